# Optimizing an MI355X kernel written in HIP

```python
import jax
import jax.numpy as jnp
from jax import lax
import numpy as np

D_MODEL = 1024
BATCH = 2
SEQ = 16384
DEPTH = 2

GRID_W = 64
CTX_LEN = 256
D_FF = 2816
FFN_RES_WEIGHT = 0.5
N_MOD = 9
EPS = 1e-6
ROPE_THETA = 10000.0
Q_BLOCK = 128
F_FLOOR = 1e-20

A_WIDTH = 256
A_GROUP = 16
A_GROUPS = A_WIDTH // A_GROUP
A_STATE = 64
DT_MIN = 1e-3
DT_MAX = 1e-1

B_HEADS = 4
B_NOPE = 64
B_ROPE = 32
B_V = 64
B_Q_LORA = 192
B_KV_LORA = 128

C_HEADS = 4
C_DK = 64
C_DV = 64
C_CHUNK = 64

D_HEADS = 4
D_KV_HEADS = 2
D_HEAD = 64

N_BRANCH = 4
BRANCH_W = 256

IN_SPLITS = (A_WIDTH,
             B_Q_LORA, B_KV_LORA, B_ROPE,
             C_HEADS * C_DK, C_HEADS * C_DV, C_HEADS * C_DK, C_HEADS * C_DK, C_HEADS * C_DV,
             D_HEADS * D_HEAD, D_KV_HEADS * D_HEAD, D_KV_HEADS * D_HEAD,
             N_BRANCH * D_MODEL)
N_IN = sum(IN_SPLITS)

kernel_name = 'hybrid_s5_mla_hgrn2_gqa_block'


def rms_norm(x, g):
    xf = x.astype(jnp.float32)
    y = xf * lax.rsqrt(jnp.mean(xf * xf, axis=-1, keepdims=True) + EPS)
    return (y * g.astype(jnp.float32)).astype(x.dtype)


def modulate(x, shift, scale):
    return x * (1.0 + scale) + shift


def swiglu(h, w1, w3, w2):
    return (jax.nn.silu(h @ w1) * (h @ w3)) @ w2


def ffn_sublayer(x, mod, j, g_pre, g_post, w1, w3, w2):
    h = modulate(rms_norm(x, g_pre), mod[:, :, 3 * j], mod[:, :, 3 * j + 1])
    return x + FFN_RES_WEIGHT * mod[:, :, 3 * j + 2] * rms_norm(swiglu(h, w1, w3, w2), g_post)


def axial_rope_tables(n_rows, rot_dim):
    rows = jnp.repeat(jnp.arange(n_rows, dtype=jnp.float32), GRID_W)
    cols = jnp.tile(jnp.arange(GRID_W, dtype=jnp.float32), n_rows)
    half = rot_dim // 2
    inv = ROPE_THETA ** (-jnp.arange(0, half, 2, dtype=jnp.float32) / half)
    ang_r = rows[:, None] * inv
    ang_c = cols[:, None] * inv
    ang = jnp.concatenate([ang_r, ang_r, ang_c, ang_c], axis=-1)
    return jnp.cos(ang), jnp.sin(ang)


def apply_axial_rope(x, cos, sin):
    q = x.shape[-1] // 4
    xr = x.reshape(x.shape[:-1] + (2, 2, q))
    rot = jnp.stack([-xr[..., 1, :], xr[..., 0, :]], axis=-2).reshape(x.shape)
    return x * cos[None, :, None, :].astype(x.dtype) + rot * sin[None, :, None, :].astype(x.dtype)


def attend_block(q, k, v, scale):
    s = jnp.einsum('bqhgd,bkhd->bhgqk', q, k, preferred_element_type=jnp.float32) * scale
    p = jax.nn.softmax(s, axis=-1).astype(v.dtype)
    return jnp.einsum('bhgqk,bkhd->bqhgd', p, v)


def blocked_attention(q, k, v, scale):
    b, lq, hq, dk = q.shape
    hkv = k.shape[2]
    nblk = lq // Q_BLOCK
    qb = q.reshape(b, nblk, Q_BLOCK, hkv, hq // hkv, dk).swapaxes(0, 1)
    ob = lax.map(lambda qi: attend_block(qi, k, v, scale), qb)
    return ob.swapaxes(0, 1).reshape(b, lq, hq, v.shape[-1])


def split_projection(z):
    offsets = np.cumsum(IN_SPLITS)[:-1].tolist()
    return jnp.split(z, offsets, axis=-1)


def s5_discretize(lam_re, lam_im, log_dt, b_re, b_im):
    lam_re = jnp.minimum(lam_re.astype(jnp.float32), -1e-4)
    lam_im = lam_im.astype(jnp.float32)
    dt = jnp.exp(log_dt.astype(jnp.float32))[:, None]
    mag = jnp.exp(lam_re * dt)
    a_re = mag * jnp.cos(lam_im * dt)
    a_im = mag * jnp.sin(lam_im * dt)
    den = lam_re * lam_re + lam_im * lam_im
    num_re = a_re - 1.0
    f_re = (num_re * lam_re + a_im * lam_im) / den
    f_im = (a_im * lam_re - num_re * lam_im) / den
    b_re = b_re.astype(jnp.float32)
    b_im = b_im.astype(jnp.float32)
    bb_re = f_re[..., None] * b_re - f_im[..., None] * b_im
    bb_im = f_re[..., None] * b_im + f_im[..., None] * b_re
    return a_re, a_im, bb_re, bb_im


def complex_combine(e1, e2):
    a1r, a1i, b1r, b1i = e1
    a2r, a2i, b2r, b2i = e2
    return (a2r * a1r - a2i * a1i, a2r * a1i + a2i * a1r,
            a2r * b1r - a2i * b1i + b2r, a2r * b1i + a2i * b1r + b2i)


def complex_scan(a_re, a_im, bu_re, bu_im, h0, reverse):
    if h0 is not None:
        h_re, h_im = h0
        first = -1 if reverse else 0
        bu_re = bu_re.at[:, first].add(a_re * h_re - a_im * h_im)
        bu_im = bu_im.at[:, first].add(a_re * h_im + a_im * h_re)
    a_re = jnp.broadcast_to(a_re, bu_re.shape)
    a_im = jnp.broadcast_to(a_im, bu_im.shape)
    _, _, x_re, x_im = lax.associative_scan(complex_combine, (a_re, a_im, bu_re, bu_im),
                                            reverse=reverse, axis=1)
    return x_re, x_im


def s5_branch(u_lat, u_ctx, lam_re, lam_im, log_dt, b_re, b_im, c_re, c_im, d_skip, w_glu, with_ctx_out):
    dt_ = u_lat.dtype
    ug_lat = u_lat.reshape(u_lat.shape[0], u_lat.shape[1], A_GROUPS, A_GROUP)
    ug_ctx = u_ctx.reshape(u_ctx.shape[0], u_ctx.shape[1], A_GROUPS, A_GROUP)
    y_lat = d_skip * u_lat
    y_ctx = d_skip * u_ctx if with_ctx_out else None
    for dr, rev in enumerate((False, True)):
        a_re, a_im, bb_re, bb_im = (t.astype(dt_) for t in s5_discretize(
            lam_re[dr], lam_im[dr], log_dt[dr], b_re[dr], b_im[dr]))
        x_ctx = complex_scan(a_re, a_im,
                             jnp.einsum('gpn,blgn->blgp', bb_re, ug_ctx),
                             jnp.einsum('gpn,blgn->blgp', bb_im, ug_ctx), None, rev)
        end = 0 if rev else -1
        x_lat = complex_scan(a_re, a_im,
                             jnp.einsum('gpn,blgn->blgp', bb_re, ug_lat),
                             jnp.einsum('gpn,blgn->blgp', bb_im, ug_lat),
                             (x_ctx[0][:, end], x_ctx[1][:, end]), rev)
        y_lat = y_lat + (jnp.einsum('gnp,blgp->blgn', c_re[dr], x_lat[0])
                         - jnp.einsum('gnp,blgp->blgn', c_im[dr], x_lat[1])).reshape(u_lat.shape)
        if with_ctx_out:
            y_ctx = y_ctx + (jnp.einsum('gnp,blgp->blgn', c_re[dr], x_ctx[0])
                             - jnp.einsum('gnp,blgp->blgn', c_im[dr], x_ctx[1])).reshape(u_ctx.shape)

    def glu(y):
        g = jax.nn.gelu(y)
        return g * jax.nn.sigmoid(g @ w_glu)
    return glu(y_lat), (glu(y_ctx) if with_ctx_out else None)


def mla_keys(ckv, kr, kv_norm, w_ukv, rope):
    b, l, _ = ckv.shape
    kv = (rms_norm(ckv, kv_norm) @ w_ukv).reshape(b, l, B_HEADS, B_NOPE + B_V)
    k_nope, v = kv[..., :B_NOPE], kv[..., B_NOPE:]
    k_rope = kr[:, :, None, :]
    if rope is not None:
        k_rope = apply_axial_rope(k_rope, *rope)
    k = jnp.concatenate([k_nope, jnp.broadcast_to(k_rope, (b, l, B_HEADS, B_ROPE))], axis=-1)
    return k, v


def mla_queries(cq, q_norm, w_uq, rope):
    b, l, _ = cq.shape
    q = (rms_norm(cq, q_norm) @ w_uq).reshape(b, l, B_HEADS, B_NOPE + B_ROPE)
    if rope is None:
        return q
    return jnp.concatenate([q[..., :B_NOPE], apply_axial_rope(q[..., B_NOPE:], *rope)], axis=-1)


def mla_branch(lat, ctx, q_norm, w_uq, kv_norm, w_ukv, rope, with_ctx_out):
    scale = (B_NOPE + B_ROPE) ** -0.5
    k_ctx, v_ctx = mla_keys(ctx[1], ctx[2], kv_norm, w_ukv, None)
    k_lat, v_lat = mla_keys(lat[1], lat[2], kv_norm, w_ukv, rope)
    q_lat = mla_queries(lat[0], q_norm, w_uq, rope)
    o_lat = blocked_attention(q_lat, jnp.concatenate([k_ctx, k_lat], axis=1),
                              jnp.concatenate([v_ctx, v_lat], axis=1), scale)
    y_lat = o_lat.reshape(o_lat.shape[0], o_lat.shape[1], B_HEADS * B_V)
    if not with_ctx_out:
        return y_lat, None
    o_ctx = blocked_attention(mla_queries(ctx[0], q_norm, w_uq, None), k_ctx, v_ctx, scale)
    return y_lat, o_ctx.reshape(o_ctx.shape[0], o_ctx.shape[1], B_HEADS * B_V)


def hgrn_gates(z, lb):
    z = z.astype(jnp.float32)
    f = lb + (1.0 - lb) * jax.nn.sigmoid(z)
    log_f = jnp.log(jnp.maximum(f, F_FLOOR))
    k = (1.0 - lb) * jax.nn.sigmoid(-z)
    return log_f, k


def hgrn_chunk_scan(q, k, v, log_f, s0):
    b, l, h, _ = q.shape
    n = l // C_CHUNK
    tri = jnp.tril(jnp.ones((C_CHUNK, C_CHUNK), dtype=bool))[None, :, :, None, None]

    def chunks(t):
        return t.reshape(b, n, C_CHUNK, h, t.shape[-1]).swapaxes(0, 1)

    def step(s, inp):
        qc, kc, vc, fc = inp
        cum = jnp.cumsum(fc, axis=1)
        o_inter = jnp.einsum('bchk,bhkv->bchv', qc * jnp.exp(cum), s)
        diff = cum[:, :, None] - cum[:, None, :]
        decay = jnp.where(tri, jnp.exp(jnp.minimum(diff, 0.0)), 0.0)
        att = jnp.einsum('bthk,bshk,btshk->bths', qc, kc, decay)
        o_intra = jnp.einsum('bths,bshv->bthv', att, vc)
        last = cum[:, -1]
        s_new = jnp.exp(last)[..., None] * s + jnp.einsum(
            'bshk,bshv->bhkv', kc * jnp.exp(last[:, None] - cum), vc)
        return s_new, o_inter + o_intra

    s_fin, o = lax.scan(step, s0, (chunks(q), chunks(k), chunks(v), chunks(log_f)))
    return o.swapaxes(0, 1).reshape(b, l, h, v.shape[-1]), s_fin


def hgrn_branch(lat, ctx, lb, o_norm, with_ctx_out):
    def heads(t):
        return t.reshape(t.shape[0], t.shape[1], C_HEADS, -1).astype(jnp.float32)

    def flip(t):
        return jnp.flip(t, axis=1)

    b = ctx[0].shape[0]
    o_lat = 0.0
    o_ctx = 0.0
    for dr in range(2):
        lb_d = lb[dr].reshape(C_HEADS, C_DK)
        streams = []
        for s in (ctx, lat):
            log_f, k = hgrn_gates(heads(s[2 + dr]), lb_d)
            t = (heads(s[0]), k, heads(s[1]), log_f)
            streams.append(tuple(flip(u) for u in t) if dr == 1 else t)
        s0 = jnp.zeros((b, C_HEADS, C_DK, C_DV), jnp.float32)
        oc, s_ctx = hgrn_chunk_scan(*streams[0], s0)
        ol, _ = hgrn_chunk_scan(*streams[1], s_ctx)
        if dr == 1:
            oc, ol = flip(oc), flip(ol)
        o_lat = o_lat + ol
        o_ctx = o_ctx + oc

    def readout(o, g):
        o = rms_norm(o, o_norm).reshape(o.shape[0], o.shape[1], C_HEADS * C_DV)
        return o.astype(g.dtype) * jax.nn.silu(g)
    return readout(o_lat, lat[4]), (readout(o_ctx, ctx[4]) if with_ctx_out else None)


def gqa_keys(kd, vd, k_norm, rope):
    b, l, _ = kd.shape
    k = rms_norm(kd.reshape(b, l, D_KV_HEADS, D_HEAD), k_norm)
    v = vd.reshape(b, l, D_KV_HEADS, D_HEAD)
    return (k if rope is None else apply_axial_rope(k, *rope)), v


def gqa_queries(qd, q_norm, rope):
    b, l, _ = qd.shape
    q = rms_norm(qd.reshape(b, l, D_HEADS, D_HEAD), q_norm)
    return q if rope is None else apply_axial_rope(q, *rope)


def gqa_branch(lat, ctx, q_norm, k_norm, rope, with_ctx_out):
    scale = D_HEAD ** -0.5
    k_ctx, v_ctx = gqa_keys(ctx[1], ctx[2], k_norm, None)
    k_lat, v_lat = gqa_keys(lat[1], lat[2], k_norm, rope)
    o_lat = blocked_attention(gqa_queries(lat[0], q_norm, rope),
                              jnp.concatenate([k_ctx, k_lat], axis=1),
                              jnp.concatenate([v_ctx, v_lat], axis=1), scale)
    y_lat = o_lat.reshape(o_lat.shape[0], o_lat.shape[1], D_HEADS * D_HEAD)
    if not with_ctx_out:
        return y_lat, None
    o_ctx = blocked_attention(gqa_queries(ctx[0], q_norm, None), k_ctx, v_ctx, scale)
    return y_lat, o_ctx.reshape(o_ctx.shape[0], o_ctx.shape[1], D_HEADS * D_HEAD)


def merge_branches(branches, gate_raw, w_branch, w_out):
    b, l, _ = gate_raw.shape
    gates = jax.nn.sigmoid(gate_raw).reshape(b, l, N_BRANCH, D_MODEL)
    merged = gates[:, :, 0] * (branches[0] @ w_branch[0])
    for i in range(1, N_BRANCH):
        merged = merged + gates[:, :, i] * (branches[i] @ w_branch[i])
    return merged @ w_out


def token_mixing(h_lat, h_ctx, w_in, s5_p, mla_p, hgrn_p, gqa_p, w_branch, w_out, rope_b, rope_d, with_ctx_out):
    zl = split_projection(h_lat @ w_in)
    zc = split_projection(h_ctx @ w_in)
    ya_l, ya_c = s5_branch(zl[0], zc[0], *s5_p, with_ctx_out)
    yb_l, yb_c = mla_branch(zl[1:4], zc[1:4], *mla_p, rope_b, with_ctx_out)
    yc_l, yc_c = hgrn_branch(zl[4:9], zc[4:9], *hgrn_p, with_ctx_out)
    yd_l, yd_c = gqa_branch(zl[9:12], zc[9:12], *gqa_p, rope_d, with_ctx_out)
    y_lat = merge_branches((ya_l, yb_l, yc_l, yd_l), zl[12], w_branch, w_out)
    if not with_ctx_out:
        return y_lat, None
    y_ctx = merge_branches((ya_c, yb_c, yc_c, yd_c), zc[12], w_branch, w_out)
    return y_lat, y_ctx


def setup_inputs(seed: int = 0) -> dict:
    key = jax.random.key(seed)
    ks = iter(jax.random.split(key, 32))
    f32 = jnp.float32

    def nrm(shape, std):
        return std * jax.random.normal(next(ks), shape, f32)

    def gain(shape):
        return 1.0 + nrm(shape, 0.02)

    L = DEPTH
    return {
        'x': nrm((BATCH, SEQ, D_MODEL), 1.0),
        'c': nrm((BATCH, D_MODEL), 1.0),
        'ctx': nrm((BATCH, CTX_LEN, D_MODEL), 1.0),
        'c_ctx': nrm((D_MODEL,), 1.0),
        'w_ada': nrm((L, D_MODEL, N_MOD * D_MODEL), 0.5 * D_MODEL ** -0.5),
        'b_ada': nrm((L, N_MOD * D_MODEL), 0.02),
        'norm_pre': gain((L, 3, D_MODEL)),
        'norm_post': gain((L, 3, D_MODEL)),
        'ffn_w1': nrm((L, 2, D_MODEL, D_FF), D_MODEL ** -0.5),
        'ffn_w3': nrm((L, 2, D_MODEL, D_FF), D_MODEL ** -0.5),
        'ffn_w2': nrm((L, 2, D_FF, D_MODEL), D_FF ** -0.5),
        'w_in': nrm((L, D_MODEL, N_IN), D_MODEL ** -0.5),
        's5_lambda_re': -0.5 + nrm((L, 2, A_GROUPS, A_STATE), 0.01),
        's5_lambda_im': jnp.pi * jnp.arange(A_STATE, dtype=f32) + nrm((L, 2, A_GROUPS, A_STATE), 0.01),
        's5_log_dt': jax.random.uniform(next(ks), (L, 2, A_GROUPS), f32,
                                        minval=float(np.log(DT_MIN)), maxval=float(np.log(DT_MAX))),
        's5_b_re': nrm((L, 2, A_GROUPS, A_STATE, A_GROUP), A_GROUP ** -0.5),
        's5_b_im': nrm((L, 2, A_GROUPS, A_STATE, A_GROUP), A_GROUP ** -0.5),
        's5_c_re': nrm((L, 2, A_GROUPS, A_GROUP, A_STATE), A_STATE ** -0.5),
        's5_c_im': nrm((L, 2, A_GROUPS, A_GROUP, A_STATE), A_STATE ** -0.5),
        's5_d': nrm((L, A_WIDTH), 1.0),
        's5_w_glu': nrm((L, A_WIDTH, A_WIDTH), A_WIDTH ** -0.5),
        'mla_q_norm': gain((L, B_Q_LORA)),
        'mla_w_uq': nrm((L, B_Q_LORA, B_HEADS * (B_NOPE + B_ROPE)), B_Q_LORA ** -0.5),
        'mla_kv_norm': gain((L, B_KV_LORA)),
        'mla_w_ukv': nrm((L, B_KV_LORA, B_HEADS * (B_NOPE + B_V)), B_KV_LORA ** -0.5),
        'hgrn_lb_raw': nrm((2, L, C_HEADS * C_DK), 0.5),
        'hgrn_o_norm': gain((L, C_DV)),
        'gqa_q_norm': gain((L, D_HEAD)),
        'gqa_k_norm': gain((L, D_HEAD)),
        'w_branch': nrm((L, N_BRANCH, BRANCH_W, D_MODEL), BRANCH_W ** -0.5),
        'w_out': nrm((L, D_MODEL, D_MODEL), D_MODEL ** -0.5),
    }


def reference(x, c, ctx, c_ctx, w_ada, b_ada, norm_pre, norm_post, ffn_w1, ffn_w3, ffn_w2, w_in,
              s5_lambda_re, s5_lambda_im, s5_log_dt, s5_b_re, s5_b_im, s5_c_re, s5_c_im, s5_d, s5_w_glu,
              mla_q_norm, mla_w_uq, mla_kv_norm, mla_w_ukv, hgrn_lb_raw, hgrn_o_norm,
              gqa_q_norm, gqa_k_norm, w_branch, w_out):
    b, seq_len, _ = x.shape
    n_rows = seq_len // GRID_W
    rope_b = axial_rope_tables(n_rows, B_ROPE)
    rope_d = axial_rope_tables(n_rows, D_HEAD)
    lb_step = jax.nn.softmax(hgrn_lb_raw.astype(jnp.float32), axis=1)
    lb_all = jnp.clip(jnp.cumsum(lb_step, axis=1) - lb_step[:, :1], 0.0, 1.0)

    x_lat, x_ctx = x, ctx
    for layer in range(DEPTH):
        last = layer == DEPTH - 1
        mod_lat = (jax.nn.silu(c) @ w_ada[layer] + b_ada[layer]).reshape(b, 1, N_MOD, D_MODEL)
        mod_ctx = (jax.nn.silu(c_ctx) @ w_ada[layer] + b_ada[layer]).reshape(1, 1, N_MOD, D_MODEL)
        ffn_a = (norm_pre[layer, 0], norm_post[layer, 0], ffn_w1[layer, 0], ffn_w3[layer, 0], ffn_w2[layer, 0])
        ffn_b = (norm_pre[layer, 2], norm_post[layer, 2], ffn_w1[layer, 1], ffn_w3[layer, 1], ffn_w2[layer, 1])

        x_lat = ffn_sublayer(x_lat, mod_lat, 0, *ffn_a)
        x_ctx = ffn_sublayer(x_ctx, mod_ctx, 0, *ffn_a)

        h_lat = modulate(rms_norm(x_lat, norm_pre[layer, 1]), mod_lat[:, :, 3], mod_lat[:, :, 4])
        h_ctx = modulate(rms_norm(x_ctx, norm_pre[layer, 1]), mod_ctx[:, :, 3], mod_ctx[:, :, 4])
        s5_p = (s5_lambda_re[layer], s5_lambda_im[layer], s5_log_dt[layer], s5_b_re[layer], s5_b_im[layer],
                s5_c_re[layer], s5_c_im[layer], s5_d[layer], s5_w_glu[layer])
        mla_p = (mla_q_norm[layer], mla_w_uq[layer], mla_kv_norm[layer], mla_w_ukv[layer])
        hgrn_p = (lb_all[:, layer], hgrn_o_norm[layer])
        gqa_p = (gqa_q_norm[layer], gqa_k_norm[layer])
        y_lat, y_ctx = token_mixing(h_lat, h_ctx, w_in[layer], s5_p, mla_p, hgrn_p, gqa_p,
                                    w_branch[layer], w_out[layer], rope_b, rope_d, not last)
        x_lat = x_lat + mod_lat[:, :, 5] * rms_norm(y_lat, norm_post[layer, 1])

        x_lat = ffn_sublayer(x_lat, mod_lat, 2, *ffn_b)
        if not last:
            x_ctx = x_ctx + mod_ctx[:, :, 5] * rms_norm(y_ctx, norm_post[layer, 1])
            x_ctx = ffn_sublayer(x_ctx, mod_ctx, 2, *ffn_b)
    return x_lat
```

```cpp
#include <hip/hip_runtime.h>
#include <hip/hip_cooperative_groups.h>
#include <cstdio>
namespace cg = cooperative_groups;

#ifndef MULTI_LAUNCH
#define MULTI_LAUNCH 0
#endif

typedef unsigned short bf;
typedef __attribute__((ext_vector_type(8))) short bf16x8;
typedef __attribute__((ext_vector_type(4))) float f32x4;
typedef __attribute__((ext_vector_type(4))) unsigned int u32x4;
typedef __attribute__((ext_vector_type(2))) unsigned int u32x2;

#define DEVI __device__ __forceinline__

constexpr int DM = 1024, RB = 16640, NR = 33280, CTXL = 256, SEQL = 16384, DFF = 2816, NIN = 6496, ZLD = 2432;
constexpr float EPS = 1e-6f;
constexpr float LOG2E = 1.4426950408889634f;
constexpr float L2_10000 = 13.287712379549449f;
constexpr int SMEM_BYTES = 73728;

struct P {
  const float *x, *c, *ctx, *c_ctx, *w_ada, *b_ada, *norm_pre, *norm_post, *w1, *w3, *w2, *w_in,
      *lam_re, *lam_im, *log_dt, *b_re, *b_im, *c_re, *c_im, *s5d, *wglu, *qn_mla, *wuq, *kvn_mla, *wukv,
      *lb_raw, *onorm, *qn_gqa, *kn_gqa, *wbr, *wout;
  float* out;
  bf *W13, *W2, *WIN, *WB, *WOUT, *WGLU, *WUQ, *WUKV;
  bf *H, *UZ, *Y, *BR;
  bf *hS, *Qd, *Kd, *VdT, *Qb, *Kb, *Vtb, *gbuf;
  float *xctx, *mod, *s5A, *s5Bre, *s5Bim, *s5E, *s5Cin, *hD;
  unsigned* bar;
};

typedef __bf16 bf16x2_t __attribute__((ext_vector_type(2)));
typedef float f32x2_t __attribute__((ext_vector_type(2)));
DEVI bf f2bf(float f) { __bf16 r = (__bf16)f; return *reinterpret_cast<bf*>(&r); }
DEVI float bf2f(bf h) { return __uint_as_float(((unsigned)h) << 16); }
DEVI unsigned pack2(float a, float b) { f32x2_t v = {a, b}; bf16x2_t r = __builtin_convertvector(v, bf16x2_t); return *reinterpret_cast<unsigned*>(&r); }
DEVI float sigm(float x) { return 1.f / (1.f + __expf(-x)); }
DEVI float silu_(float x) { return x / (1.f + __expf(-x)); }
DEVI float gelu_tanh(float x) {
  float u = 0.7978845608028654f * (x + 0.044715f * x * x * x);
  float t = 1.f - 2.f / (1.f + __expf(2.f * u));
  return 0.5f * x * (1.f + t);
}
DEVI float ex2(float x) { return __builtin_amdgcn_exp2f(x); }
DEVI float wave_sum(float v) {
#pragma unroll
  for (int o = 32; o > 0; o >>= 1) v += __shfl_xor(v, o);
  return v;
}
DEVI int get_tid() { int t = threadIdx.x; asm volatile("" : "+v"(t)); return t; }
DEVI f32x4 mfma16(bf16x8 a, bf16x8 b, f32x4 c) { return __builtin_amdgcn_mfma_f32_16x16x32_bf16(a, b, c, 0, 0, 0); }
DEVI bf16x8 as_bf8(u32x4 v) { return *reinterpret_cast<bf16x8*>(&v); }

DEVI bool tile_map(int v, int ntn, int& mt, int& nt) {
  const int x = v & 7, idx = v >> 3;
  const int cm = (260 - x + 7) >> 3;
  const int full = 32 * ntn;
  int ml;
  if (idx < full) {
    const int per = 8 * ntn;
    const int gi = idx / per, within = idx - gi * per;
    nt = within >> 3;
    ml = gi * 8 + (within & 7);
  } else {
    const int k = idx - full;
    const int gs = cm - 32;
    if (k >= gs * ntn) return false;
    nt = k / gs;
    ml = 32 + (k - nt * gs);
  }
  mt = x + 8 * ml;
  return true;
}
constexpr int TILE_V(int ntn) { return 8 * 33 * ntn; }

template <int NTW, bool ROWSS>
DEVI void gemm_core(f32x4 (&acc)[4][NTW], const bf* __restrict__ A, int lda, const bf* __restrict__ Bt, int ldb, int K,
                    char* smem, float* rowss) {
  constexpr int BN = 32 * NTW;
  constexpr int ASZ = 128 * 144;
  constexpr int BSZ = BN * 144;
  constexpr int STG = ASZ + BSZ;
  constexpr int NBL = BN / 32;
  const int tid = get_tid(), lane = tid & 63, w = tid >> 6, wr = w >> 1, wc = w & 1, l15 = lane & 15, quad = lane >> 4;
  const int lr = tid >> 3, lc = (tid & 7) * 8;
  u32x4 ra[4], rb[NBL];
  float ss[4] = {0.f, 0.f, 0.f, 0.f};
  const int nk = K >> 6;
#pragma unroll
  for (int i = 0; i < 4; ++i) ra[i] = *reinterpret_cast<const u32x4*>(A + (long)(lr + 32 * i) * lda + lc);
#pragma unroll
  for (int i = 0; i < NBL; ++i) rb[i] = *reinterpret_cast<const u32x4*>(Bt + (long)(lr + 32 * i) * ldb + lc);
  {
#pragma unroll
    for (int i = 0; i < 4; ++i) *reinterpret_cast<u32x4*>(smem + (lr + 32 * i) * 144 + lc * 2) = ra[i];
#pragma unroll
    for (int i = 0; i < NBL; ++i) *reinterpret_cast<u32x4*>(smem + ASZ + (lr + 32 * i) * 144 + lc * 2) = rb[i];
    if (ROWSS) {
#pragma unroll
      for (int i = 0; i < 4; ++i)
#pragma unroll
        for (int e = 0; e < 4; ++e) {
          unsigned u = ra[i][e];
          float lo = __uint_as_float(u << 16), hi = __uint_as_float(u & 0xffff0000u);
          ss[i] += lo * lo + hi * hi;
        }
    }
  }
  __syncthreads();
  for (int kt = 0; kt < nk; ++kt) {
    const bool more = (kt + 1 < nk);
    if (more) {
      const int k0 = (kt + 1) * 64;
#pragma unroll
      for (int i = 0; i < 4; ++i) ra[i] = *reinterpret_cast<const u32x4*>(A + (long)(lr + 32 * i) * lda + k0 + lc);
#pragma unroll
      for (int i = 0; i < NBL; ++i) rb[i] = *reinterpret_cast<const u32x4*>(Bt + (long)(lr + 32 * i) * ldb + k0 + lc);
    }
    const char* base = smem + (kt & 1) * STG;
#pragma unroll
    for (int ks = 0; ks < 2; ++ks) {
      bf16x8 af[4], bfr[NTW];
#pragma unroll
      for (int m = 0; m < 4; ++m)
        af[m] = *reinterpret_cast<const bf16x8*>(base + (wr * 64 + m * 16 + l15) * 144 + (ks * 32 + quad * 8) * 2);
#pragma unroll
      for (int n = 0; n < NTW; ++n)
        bfr[n] = *reinterpret_cast<const bf16x8*>(base + ASZ + (wc * 16 * NTW + n * 16 + l15) * 144 + (ks * 32 + quad * 8) * 2);
#pragma unroll
      for (int m = 0; m < 4; ++m)
#pragma unroll
        for (int n = 0; n < NTW; ++n) acc[m][n] = mfma16(af[m], bfr[n], acc[m][n]);
    }
    if (more) {
      char* nb = smem + ((kt + 1) & 1) * STG;
#pragma unroll
      for (int i = 0; i < 4; ++i) *reinterpret_cast<u32x4*>(nb + (lr + 32 * i) * 144 + lc * 2) = ra[i];
#pragma unroll
      for (int i = 0; i < NBL; ++i) *reinterpret_cast<u32x4*>(nb + ASZ + (lr + 32 * i) * 144 + lc * 2) = rb[i];
      if (ROWSS) {
#pragma unroll
        for (int i = 0; i < 4; ++i)
#pragma unroll
          for (int e = 0; e < 4; ++e) {
            unsigned u = ra[i][e];
            float lo = __uint_as_float(u << 16), hi = __uint_as_float(u & 0xffff0000u);
            ss[i] += lo * lo + hi * hi;
          }
      }
    }
    __syncthreads();
  }
  if (ROWSS) {
#pragma unroll
    for (int i = 0; i < 4; ++i) {
      float s = ss[i];
      s += __shfl_xor(s, 1); s += __shfl_xor(s, 2); s += __shfl_xor(s, 4);
      if ((tid & 7) == 0) rowss[lr + 32 * i] = s;
    }
    __syncthreads();
  }
}


DEVI void glds16(const bf* g, char* l) {
  __builtin_amdgcn_global_load_lds((const unsigned*)g, (__attribute__((address_space(3))) unsigned*)l, 16, 0, 0);
}

template <int NTW, bool SPLIT = false, bool HALFA = false>
DEVI void gemm_core2(f32x4 (&acc)[4][NTW], const bf* __restrict__ A, int lda, const bf* __restrict__ Bt, int ldb, int K, char* smem) {
  constexpr int BN = 32 * NTW;
  constexpr int ASZ = 128 * 128;
  constexpr int BSZ = BN * 128;
  constexpr int STG = ASZ + BSZ;
  constexpr int NBL = BN / 32;
  const int tid = get_tid(), lane = tid & 63, w = tid >> 6, wr = w >> 1, wc = w & 1, l15 = lane & 15, quad = lane >> 4;
  const int lr = tid >> 3, pch = tid & 7;
  const int lch = pch ^ (lr & 7);
  const int nk = K >> 6;
  const bf* Ap = A + (long)lr * lda + lch * 8;
  const bf* Bp = Bt + (long)lr * ldb + lch * 8;
  const long sa = (long)32 * lda, sb = (long)32 * ldb;
  char* dbase = smem + tid * 16;
  const int sw0 = ((quad ^ (l15 & 7)) << 4), sw1 = (((4 + quad) ^ (l15 & 7)) << 4);
  const char* abase = smem + (wr * 64 + l15) * 128;
  const char* bbase = smem + ASZ + (wc * 16 * NTW + l15) * 128;
#pragma unroll
  for (int i = 0; i < 4; ++i) glds16(Ap + i * sa, dbase + i * 4096);
#pragma unroll
  for (int i = 0; i < NBL; ++i) glds16(Bp + i * sb, dbase + ASZ + i * 4096);
  __syncthreads();
  const int klast = K - 64;
  for (int kt = 0; kt < nk; ++kt) {
    const int k1 = min((kt + 1) * 64, klast);
    const int so = (kt & 1) * STG, sn = ((kt + 1) & 1) * STG;
    if (!SPLIT) {
      bf16x8 af[2][4], bfr[2][NTW];
#pragma unroll
      for (int ks = 0; ks < 2; ++ks) {
        const int swz = ks ? sw1 : sw0;
#pragma unroll
        for (int m = 0; m < 4; ++m) af[ks][m] = *reinterpret_cast<const bf16x8*>(abase + so + m * 16 * 128 + swz);
#pragma unroll
        for (int n = 0; n < NTW; ++n) bfr[ks][n] = *reinterpret_cast<const bf16x8*>(bbase + so + n * 16 * 128 + swz);
      }
#pragma unroll
      for (int i = 0; i < 4; ++i) glds16(Ap + i * sa + k1, dbase + sn + i * 4096);
#pragma unroll
      for (int i = 0; i < NBL; ++i) glds16(Bp + i * sb + k1, dbase + sn + ASZ + i * 4096);
      __builtin_amdgcn_s_setprio(1);
#pragma unroll
      for (int ks = 0; ks < 2; ++ks)
#pragma unroll
        for (int m = 0; m < 4; ++m)
#pragma unroll
          for (int n = 0; n < NTW; ++n) acc[m][n] = mfma16(af[ks][m], bfr[ks][n], acc[m][n]);
    } else {
      if (HALFA) {
#pragma unroll
        for (int ks = 0; ks < 2; ++ks) {
          const int swz = ks ? sw1 : sw0;
          bf16x8 bfr[NTW];
#pragma unroll
          for (int n = 0; n < NTW; ++n) bfr[n] = *reinterpret_cast<const bf16x8*>(bbase + so + n * 16 * 128 + swz);
#pragma unroll
          for (int mh = 0; mh < 2; ++mh) {
            bf16x8 af[2];
#pragma unroll
            for (int m = 0; m < 2; ++m) af[m] = *reinterpret_cast<const bf16x8*>(abase + so + (mh * 2 + m) * 16 * 128 + swz);
            if (ks == 1 && mh == 1) {
#pragma unroll
              for (int i = 0; i < 4; ++i) glds16(Ap + i * sa + k1, dbase + sn + i * 4096);
#pragma unroll
              for (int i = 0; i < NBL; ++i) glds16(Bp + i * sb + k1, dbase + sn + ASZ + i * 4096);
            }
#pragma unroll
            for (int m = 0; m < 2; ++m)
#pragma unroll
              for (int n = 0; n < NTW; ++n) acc[mh * 2 + m][n] = mfma16(af[m], bfr[n], acc[mh * 2 + m][n]);
          }
        }
      } else
#pragma unroll
      for (int ks = 0; ks < 2; ++ks) {
        const int swz = ks ? sw1 : sw0;
        bf16x8 af[4], bfr[NTW];
#pragma unroll
        for (int m = 0; m < 4; ++m) af[m] = *reinterpret_cast<const bf16x8*>(abase + so + m * 16 * 128 + swz);
#pragma unroll
        for (int n = 0; n < NTW; ++n) bfr[n] = *reinterpret_cast<const bf16x8*>(bbase + so + n * 16 * 128 + swz);
        if (ks == 1) {
#pragma unroll
          for (int i = 0; i < 4; ++i) glds16(Ap + i * sa + k1, dbase + sn + i * 4096);
#pragma unroll
          for (int i = 0; i < NBL; ++i) glds16(Bp + i * sb + k1, dbase + sn + ASZ + i * 4096);
        }
        __builtin_amdgcn_s_setprio(1);
#pragma unroll
        for (int m = 0; m < 4; ++m)
#pragma unroll
          for (int n = 0; n < NTW; ++n) acc[m][n] = mfma16(af[m], bfr[n], acc[m][n]);
        __builtin_amdgcn_s_setprio(0);
      }
    }
    __builtin_amdgcn_s_setprio(0);
    __syncthreads();
  }
}

DEVI void gemm_core3(f32x4 (&acc)[8][4], const bf* __restrict__ A, int lda, const bf* __restrict__ Bt, int ldb, int K, char* smem) {
  constexpr int ASZ = 256 * 64, BSZ = 128 * 64, STG = ASZ + BSZ;
  const int tid = get_tid(), lane = tid & 63, w = tid >> 6, wr = w >> 1, wc = w & 1, l15 = lane & 15, quad = lane >> 4;
  const int lr = tid >> 2, ch = tid & 3;
  const int nk = K >> 5;
  const int lch = ch ^ (((lr >> 3) & 1) << 1);
  const bf* Ap = A + (long)lr * lda + lch * 8;
  const bf* Bp = Bt + (long)lr * ldb + lch * 8;
  const long sa = (long)64 * lda, sb = (long)64 * ldb;
  char* dbase = smem + tid * 16;
  const int rsw = (quad ^ (((l15 >> 3) & 1) << 1)) << 4;
  const char* abase = smem + (wr * 128 + l15) * 64 + rsw;
  const char* bbase = smem + ASZ + (wc * 64 + l15) * 64 + rsw;
#pragma unroll
  for (int i = 0; i < 4; ++i) glds16(Ap + i * sa, dbase + i * 4096);
#pragma unroll
  for (int i = 0; i < 2; ++i) glds16(Bp + i * sb, dbase + ASZ + i * 4096);
  __syncthreads();
  const int klast = K - 32;
  for (int kt = 0; kt < nk; ++kt) {
    const int k1 = min((kt + 1) * 32, klast);
    const int sn = ((kt + 1) & 1) * STG;
    const int so = (kt & 1) * STG;
    bf16x8 bfr[4], af[8];
#pragma unroll
    for (int n = 0; n < 4; ++n) bfr[n] = *reinterpret_cast<const bf16x8*>(bbase + so + n * 16 * 64);
#pragma unroll
    for (int m = 0; m < 8; ++m) af[m] = *reinterpret_cast<const bf16x8*>(abase + so + m * 16 * 64);
#pragma unroll
    for (int i = 0; i < 4; ++i) glds16(Ap + i * sa + k1, dbase + sn + i * 4096);
#pragma unroll
    for (int i = 0; i < 2; ++i) glds16(Bp + i * sb + k1, dbase + sn + ASZ + i * 4096);
    __builtin_amdgcn_s_setprio(1);
#pragma unroll
    for (int m = 0; m < 8; ++m)
#pragma unroll
      for (int n = 0; n < 4; ++n) acc[m][n] = mfma16(af[m], bfr[n], acc[m][n]);
    __builtin_amdgcn_s_setprio(0);
    __syncthreads();
  }
}
template <int BN>
DEVI void tile_store256(const char* smem, bf* __restrict__ C, long ldc, long row0, int col0) {
  constexpr int LDT = BN + 8;
  constexpr int CPR = BN / 8;
  const int tid = get_tid();
#pragma unroll
  for (int i = 0; i < CPR; ++i) {
    const int q = tid + 256 * i;
    const int r = q / CPR, c = q - r * CPR;
    u32x4 v = *reinterpret_cast<const u32x4*>(smem + (r * LDT + c * 8) * 2);
    *reinterpret_cast<u32x4*>(C + (row0 + r) * ldc + col0 + c * 8) = v;
  }
}
DEVI long lat_row0_256(int m2) { return m2 < 64 ? (long)CTXL + (long)m2 * 256 : (long)RB + CTXL + (long)(m2 - 64) * 256; }
DEVI void lat_tile_map256(int v, int ntn, int& m2, int& nt) {
  const int x = v & 7, idx = v >> 3;
  const int per = 8 * ntn;
  const int gi = idx / per, within = idx - gi * per;
  nt = within >> 3;
  m2 = x + 8 * (gi * 8 + (within & 7));
}

template <int NTW>
DEVI void zero_acc(f32x4 (&acc)[4][NTW]) {
#pragma unroll
  for (int m = 0; m < 4; ++m)
#pragma unroll
    for (int n = 0; n < NTW; ++n) acc[m][n] = f32x4{0.f, 0.f, 0.f, 0.f};
}


template <int BN>
DEVI void tile_store(const char* smem, bf* __restrict__ C, long ldc, long row0, int col0) {
  constexpr int LDT = BN + 8;
  const int tid = get_tid();
  const int r = tid >> 1, half = tid & 1;
#pragma unroll
  for (int c = 0; c < BN / 16; ++c) {
    u32x4 v = *reinterpret_cast<const u32x4*>(smem + (r * LDT + half * (BN / 2) + c * 8) * 2);
    *reinterpret_cast<u32x4*>(C + (row0 + r) * ldc + col0 + half * (BN / 2) + c * 8) = v;
  }
}

DEVI void conv_tile(const P& p, int l, int job, int tile, char* smem) {
  float* tl = reinterpret_cast<float*>(smem);
  const int tid = get_tid();
  int Np, K, ld;
  const float* src = nullptr; const float* src2 = nullptr; const float* gv = nullptr; bf* dst = nullptr;
  if (job < 2) { Np = 5632; K = 1024; ld = DFF; src = p.w1 + (long)(l * 2 + job) * DM * DFF; src2 = p.w3 + (long)(l * 2 + job) * DM * DFF; dst = p.W13 + (long)job * 5632 * 1024; }
  else if (job < 4) { Np = 1024; K = DFF; ld = DM; src = p.w2 + (long)(l * 2 + job - 2) * DFF * DM; dst = p.W2 + (long)(job - 2) * 1024 * DFF; }
  else if (job == 4) { Np = NIN; K = 1024; ld = NIN; src = p.w_in + (long)l * DM * NIN; dst = p.WIN; }
  else if (job < 9) { Np = 1024; K = 256; ld = DM; src = p.wbr + (long)(l * 4 + job - 5) * 256 * DM; dst = p.WB + (long)(job - 5) * 1024 * 256; }
  else if (job == 9) { Np = 1024; K = 1024; ld = DM; src = p.wout + (long)l * DM * DM; dst = p.WOUT; }
  else if (job == 10) { Np = 256; K = 256; ld = 256; src = p.wglu + (long)l * 256 * 256; dst = p.WGLU; }
  else if (job == 11) { Np = 512; K = 192; ld = 384; src = p.wuq + (long)l * 192 * 384; gv = p.qn_mla + l * 192; dst = p.WUQ; }
  else { Np = 512; K = 128; ld = 512; src = p.wukv + (long)l * 128 * 512; gv = p.kvn_mla + l * 128; dst = p.WUKV; }
  const int nkt = K >> 6;
  const int tn = tile / nkt, tk = tile - tn * nkt;
  const int n0 = tn * 64, k0 = tk * 64;
  {
    const int kk = tid >> 2, seg = (tid & 3) * 16;
    const int k = k0 + kk;
    const float gs = gv ? gv[k] : 1.f;
    if (job != 11) {
      const int np0 = n0 + seg;
      f32x4 q4[4];
#pragma unroll
      for (int c = 0; c < 4; ++c) q4[c] = f32x4{0.f, 0.f, 0.f, 0.f};
      if (np0 < Np) {
        const float* sp;
        if (job < 2) sp = (((np0 >> 4) & 1) ? src2 : src) + (long)k * ld + 16 * (np0 >> 5);
        else sp = src + (long)k * ld + np0;
#pragma unroll
        for (int c = 0; c < 4; ++c) q4[c] = *reinterpret_cast<const f32x4*>(sp + 4 * c);
      }
#pragma unroll
      for (int c = 0; c < 4; ++c)
#pragma unroll
        for (int e = 0; e < 4; ++e) tl[kk * 65 + seg + 4 * c + e] = q4[c][e] * gs;
    } else
#pragma unroll 4
    for (int e = 0; e < 16; ++e) {
      const int np = n0 + seg + e;
      float val = 0.f;
      if (np < Np) {
        if (job < 2) {
          int cidx = 16 * (np >> 5) + (np & 15);
          int s = (np >> 4) & 1;
          val = (s ? src2 : src)[(long)k * ld + cidx];
        } else if (job == 11) {
          int h = np >> 7, cp = np & 127;
          if (cp < 64) val = src[(long)k * ld + h * 96 + cp];
          else {
            int c2 = cp - 64, blk = c2 >> 4, e2 = c2 & 15;
            int rho = (blk >> 1) * 16 + e2;
            if (blk & 1) {
              if ((rho & 8) == 0) val = -src[(long)k * ld + h * 96 + 64 + rho + 8];
              else val = src[(long)k * ld + h * 96 + 64 + rho - 8];
            } else val = src[(long)k * ld + h * 96 + 64 + rho];
          }
          val *= gs;
        } else {
          val = src[(long)k * ld + np] * gs;
        }
      }
      tl[kk * 65 + seg + e] = val;
    }
  }
  __syncthreads();
  {
    const int n = tid >> 2, ksg = (tid & 3) * 16;
    if (n0 + n < Np) {
      u32x4 o0, o1;
#pragma unroll
      for (int e = 0; e < 4; ++e) {
        o0[e] = pack2(tl[(ksg + 2 * e) * 65 + n], tl[(ksg + 2 * e + 1) * 65 + n]);
        o1[e] = pack2(tl[(ksg + 8 + 2 * e) * 65 + n], tl[(ksg + 8 + 2 * e + 1) * 65 + n]);
      }
      bf* d = dst + (long)(n0 + n) * K + k0 + ksg;
      *reinterpret_cast<u32x4*>(d) = o0;
      *reinterpret_cast<u32x4*>(d + 8) = o1;
    }
  }
  __syncthreads();
}

DEVI void phase_conv(const P& p, int l, char* smem, int item0, int nblk) {
  const int cnt[13] = {1408, 1408, 704, 704, 102 * 16, 64, 64, 64, 64, 256, 16, 24, 16};
  int total = 0;
#pragma unroll
  for (int j = 0; j < 13; ++j) total += cnt[j];
  for (int it = item0; it < total; it += nblk) {
    int job = 0, r = it;
#pragma unroll
    for (int j = 0; j < 13; ++j) { if (job == j && r >= cnt[j]) { r -= cnt[j]; job = j + 1; } }
    conv_tile(p, l, job, r, smem);
  }
}
constexpr int CONV_ITEMS = 1408 * 2 + 704 * 2 + 102 * 16 + 64 * 4 + 256 + 16 + 24 + 16;

DEVI void mods_item(const P& p, int it, char* smem) {
  const int l = it / 144, cb = it % 144;
  float* sc = reinterpret_cast<float*>(smem);
  float* part = sc + 3 * 1024;
  const int tid = get_tid(), lane = tid & 63, w = tid >> 6;
  for (int i = tid; i < 3 * 1024; i += 256) {
    int g = i >> 10, k = i & 1023;
    float v = (g < 2) ? p.c[g * 1024 + k] : p.c_ctx[k];
    sc[i] = silu_(v);
  }
  __syncthreads();
  const int col = cb * 64 + lane;
  const float* wp = p.w_ada + ((long)l * 1024 + w * 256) * 9216 + col;
  float a0 = 0.f, a1 = 0.f, a2 = 0.f;
#pragma unroll 32
  for (int k = 0; k < 256; ++k) {
    float wv = wp[(long)k * 9216];
    a0 += sc[w * 256 + k] * wv; a1 += sc[1024 + w * 256 + k] * wv; a2 += sc[2048 + w * 256 + k] * wv;
  }
  part[(w * 3 + 0) * 64 + lane] = a0; part[(w * 3 + 1) * 64 + lane] = a1; part[(w * 3 + 2) * 64 + lane] = a2;
  __syncthreads();
  if (tid < 192) {
    int g = tid >> 6, ln = tid & 63;
    float s = part[(0 * 3 + g) * 64 + ln] + part[(1 * 3 + g) * 64 + ln] + part[(2 * 3 + g) * 64 + ln] + part[(3 * 3 + g) * 64 + ln];
    int cc = cb * 64 + ln;
    p.mod[((long)(l * 3 + g)) * 9216 + cc] = s + p.b_ada[l * 9216 + cc];
  }
  __syncthreads();
}

DEVI void s5disc_item(const P& p, int it) {
  const int idx = it * 256 + get_tid();
  const int pp = idx & 63, g = (idx >> 6) & 15, d = (idx >> 10) & 1, l = idx >> 11;
  const int ldg = (l * 2 + d) * 16 + g;
  float lre = fminf(p.lam_re[ldg * 64 + pp], -1e-4f);
  float lim = p.lam_im[ldg * 64 + pp];
  float dt = expf(p.log_dt[ldg]);
  float mag = expf(lre * dt);
  float are = mag * cosf(lim * dt), aim = mag * sinf(lim * dt);
  float den = lre * lre + lim * lim;
  float nre = are - 1.f;
  float fre = (nre * lre + aim * lim) / den;
  float fim = (aim * lre - nre * lim) / den;
  p.s5A[(ldg * 64 + pp) * 2] = are; p.s5A[(ldg * 64 + pp) * 2 + 1] = aim;
#pragma unroll 4
  for (int n = 0; n < 16; ++n) {
    float br = p.b_re[((long)ldg * 64 + pp) * 16 + n], bi = p.b_im[((long)ldg * 64 + pp) * 16 + n];
    p.s5Bre[((long)ldg * 16 + n) * 64 + pp] = fre * br - fim * bi;
    p.s5Bim[((long)ldg * 16 + n) * 64 + pp] = fre * bi + fim * br;
  }
}

DEVI void phase_rowpass(const P& p, bool first_in, bool has_y, float resw, const float* modg  , int gate_idx,
                        const float* gpost, bool has_h, const float* modh, int shift_idx, const float* gpre) {
  const int tid = get_tid(), lane = tid & 63, w = tid >> 6;
  const int gw = blockIdx.x * 4 + w, nw = gridDim.x * 4;
  int rpw = (NR + nw - 1) / nw;
  rpw += rpw & 1;
  const int r0 = gw * rpw, r1 = min(r0 + rpw, NR);
  int cur = -1;
  f32x4 gg[4], ps[4], sh[4];
#pragma unroll
  for (int i = 0; i < 4; ++i) { gg[i] = f32x4{0.f, 0.f, 0.f, 0.f}; ps[i] = gg[i]; sh[i] = gg[i]; }
  for (int r = r0; r < r1; r += 2) {
    const int b = r / RB, j = r - b * RB;
    const bool isctx = j < CTXL;
    const int grp = isctx ? 2 : b;
    if (grp != cur) {
      cur = grp;
      if (has_y) {
        const float* gt = modg + ((long)grp * 9 + gate_idx) * DM;
#pragma unroll
        for (int i = 0; i < 4; ++i) {
          f32x4 g4 = *reinterpret_cast<const f32x4*>(gt + i * 256 + lane * 4);
          f32x4 gp = *reinterpret_cast<const f32x4*>(gpost + i * 256 + lane * 4);
#pragma unroll
          for (int e = 0; e < 4; ++e) gg[i][e] = g4[e] * gp[e] * resw;
        }
      }
      if (has_h) {
        const float* shp = modh + ((long)grp * 9 + shift_idx) * DM;
        const float* scl = shp + DM;
#pragma unroll
        for (int i = 0; i < 4; ++i) {
          f32x4 c4 = *reinterpret_cast<const f32x4*>(scl + i * 256 + lane * 4);
          f32x4 gp = *reinterpret_cast<const f32x4*>(gpre + i * 256 + lane * 4);
          sh[i] = *reinterpret_cast<const f32x4*>(shp + i * 256 + lane * 4);
#pragma unroll
          for (int e = 0; e < 4; ++e) ps[i][e] = gp[e] * (1.f + c4[e]);
        }
      }
    }
    const float* xin; float* xout;
    if (isctx) { xout = p.xctx + (long)(b * CTXL + j) * DM; xin = first_in ? p.ctx + (long)(b * CTXL + j) * DM : xout; }
    else { xout = p.out + ((long)b * SEQL + (j - CTXL)) * DM; xin = first_in ? p.x + ((long)b * SEQL + (j - CTXL)) * DM : xout; }
    f32x4 xv[2][4];
    u32x2 yu[2][4];
#pragma unroll
    for (int q = 0; q < 2; ++q)
#pragma unroll
      for (int i = 0; i < 4; ++i) xv[q][i] = *reinterpret_cast<const f32x4*>(xin + q * DM + i * 256 + lane * 4);
    if (has_y) {
#pragma unroll
      for (int q = 0; q < 2; ++q)
#pragma unroll
        for (int i = 0; i < 4; ++i) yu[q][i] = *reinterpret_cast<const u32x2*>(p.Y + (long)(r + q) * DM + i * 256 + lane * 4);
#pragma unroll
      for (int q = 0; q < 2; ++q) {
        float yv[4][4];
        float ss = 0.f;
#pragma unroll
        for (int i = 0; i < 4; ++i) {
          yv[i][0] = __uint_as_float(yu[q][i][0] << 16); yv[i][1] = __uint_as_float(yu[q][i][0] & 0xffff0000u);
          yv[i][2] = __uint_as_float(yu[q][i][1] << 16); yv[i][3] = __uint_as_float(yu[q][i][1] & 0xffff0000u);
#pragma unroll
          for (int e = 0; e < 4; ++e) ss += yv[i][e] * yv[i][e];
        }
        ss = wave_sum(ss);
        const float rs = rsqrtf(ss * (1.f / DM) + EPS);
#pragma unroll
        for (int i = 0; i < 4; ++i) {
#pragma unroll
          for (int e = 0; e < 4; ++e) xv[q][i][e] += gg[i][e] * (yv[i][e] * rs);
          *reinterpret_cast<f32x4*>(xout + q * DM + i * 256 + lane * 4) = xv[q][i];
        }
      }
    }
    if (has_h) {
#pragma unroll
      for (int q = 0; q < 2; ++q) {
        float ss = 0.f;
#pragma unroll
        for (int i = 0; i < 4; ++i)
#pragma unroll
          for (int e = 0; e < 4; ++e) ss += xv[q][i][e] * xv[q][i][e];
        ss = wave_sum(ss);
        const float rs = rsqrtf(ss * (1.f / DM) + EPS);
#pragma unroll
        for (int i = 0; i < 4; ++i) {
          float h0 = xv[q][i][0] * rs * ps[i][0] + sh[i][0];
          float h1 = xv[q][i][1] * rs * ps[i][1] + sh[i][1];
          float h2 = xv[q][i][2] * rs * ps[i][2] + sh[i][2];
          float h3 = xv[q][i][3] * rs * ps[i][3] + sh[i][3];
          u32x2 o; o[0] = pack2(h0, h1); o[1] = pack2(h2, h3);
          *reinterpret_cast<u32x2*>(p.H + (long)(r + q) * DM + i * 256 + lane * 4) = o;
        }
      }
    }
  }
}

DEVI long lat_row0(int mtl) { return mtl < 128 ? (long)CTXL + (long)mtl * 128 : (long)RB + CTXL + (long)(mtl - 128) * 128; }
DEVI long ctx_row0(int c) { return (long)(c >> 1) * RB + (long)(c & 1) * 128; }
DEVI void lat_tile_map(int v, int ntn, int& mtl, int& nt) {
  const int x = v & 7, idx = v >> 3;
  const int per = 8 * ntn;
  const int gi = idx / per, within = idx - gi * per;
  nt = within >> 3;
  mtl = x + 8 * (gi * 8 + (within & 7));
}

template <int NTW>
DEVI void ffn1_tile(const P& p, const bf* W, long row0, int n0  , char* smem) {
  const int tid = get_tid(), lane = tid & 63, w = tid >> 6, wr = w >> 1, wc = w & 1, l15 = lane & 15, quad = lane >> 4;
  constexpr int OW = 16 * NTW;
  constexpr int LDT = OW + 8;
  f32x4 acc[4][NTW];
  zero_acc<NTW>(acc);
  gemm_core2<NTW>(acc, p.H + row0 * DM, DM, W + (long)n0 * 1024, 1024, 1024, smem);
  bf* tl = reinterpret_cast<bf*>(smem);
#pragma unroll
  for (int m = 0; m < 4; ++m)
#pragma unroll
    for (int pr = 0; pr < NTW / 2; ++pr) {
      const int cl = (wc * (NTW / 2) + pr) * 16 + l15;
#pragma unroll
      for (int j = 0; j < 4; ++j) {
        const int rl = wr * 64 + m * 16 + quad * 4 + j;
        float a = acc[m][2 * pr][j], b = acc[m][2 * pr + 1][j];
        tl[rl * LDT + cl] = f2bf(silu_(a) * b);
      }
    }
  __syncthreads();
  tile_store<OW>(smem, p.UZ, DFF, row0, n0 / 2);
  __syncthreads();
}


DEVI void ffn1_tile256(const P& p, const bf* W, long row0, int n0  , char* smem) {
  const int tid = get_tid(), lane = tid & 63, w = tid >> 6, wr = w >> 1, wc = w & 1, l15 = lane & 15, quad = lane >> 4;
  f32x4 acc[8][4];
#pragma unroll
  for (int m = 0; m < 8; ++m)
#pragma unroll
    for (int n = 0; n < 4; ++n) acc[m][n] = f32x4{0.f, 0.f, 0.f, 0.f};
  gemm_core3(acc, p.H + row0 * DM, DM, W + (long)n0 * 1024, 1024, 1024, smem);
  bf* tl = reinterpret_cast<bf*>(smem);
#pragma unroll
  for (int m = 0; m < 8; ++m)
#pragma unroll
    for (int pr = 0; pr < 2; ++pr) {
      const int cl = (wc * 2 + pr) * 16 + l15;
#pragma unroll
      for (int j = 0; j < 4; ++j) {
        const int rl = wr * 128 + m * 16 + quad * 4 + j;
        float a = acc[m][2 * pr][j], b = acc[m][2 * pr + 1][j];
        tl[rl * 72 + cl] = f2bf(silu_(a) * b);
      }
    }
  __syncthreads();
  tile_store256<64>(smem, p.UZ, DFF, row0, n0 / 2);
  __syncthreads();
}
DEVI void plain_tile256(const bf* A, int lda, const bf* Wt, int K, bf* C, int ldc, long row0, int n0, char* smem) {
  const int tid = get_tid(), lane = tid & 63, w = tid >> 6, wr = w >> 1, wc = w & 1, l15 = lane & 15, quad = lane >> 4;
  f32x4 acc[8][4];
#pragma unroll
  for (int m = 0; m < 8; ++m)
#pragma unroll
    for (int n = 0; n < 4; ++n) acc[m][n] = f32x4{0.f, 0.f, 0.f, 0.f};
  gemm_core3(acc, A + row0 * lda, lda, Wt + (long)n0 * K, K, K, smem);
  bf* tl = reinterpret_cast<bf*>(smem);
#pragma unroll
  for (int m = 0; m < 8; ++m)
#pragma unroll
    for (int n = 0; n < 4; ++n) {
      const int cl = wc * 64 + n * 16 + l15;
#pragma unroll
      for (int j = 0; j < 4; ++j) tl[(wr * 128 + m * 16 + quad * 4 + j) * 136 + cl] = f2bf(acc[m][n][j]);
    }
  __syncthreads();
  tile_store256<128>(smem, C, ldc, row0, n0);
  __syncthreads();
}

DEVI void phase_ffn1(const P& p, int f, char* smem) {
  const bf* W = p.W13 + (long)f * 5632 * 1024;
  for (int v = blockIdx.x; v < 128 * 44; v += gridDim.x) {
    int m2, nt;
    lat_tile_map256(v, 44, m2, nt);
    ffn1_tile256(p, W, lat_row0_256(m2), nt * 128, smem);
  }
  for (int u = blockIdx.x; u < 4 * 88; u += gridDim.x) ffn1_tile<2>(p, W, ctx_row0(u & 3), (u >> 2) * 64, smem);
}

template <int NTW>
DEVI void plain_tile(const bf* A, int lda, const bf* Wt, int K, bf* C, int ldc, long row0, int n0, char* smem) {
  const int tid = get_tid(), lane = tid & 63, w = tid >> 6, wr = w >> 1, wc = w & 1, l15 = lane & 15, quad = lane >> 4;
  constexpr int BN = 32 * NTW;
  constexpr int LDT = BN + 8;
  f32x4 acc[4][NTW];
  zero_acc<NTW>(acc);
  gemm_core2<NTW>(acc, A + row0 * lda, lda, Wt + (long)n0 * K, K, K, smem);
  bf* tl = reinterpret_cast<bf*>(smem);
#pragma unroll
  for (int m = 0; m < 4; ++m)
#pragma unroll
    for (int n = 0; n < NTW; ++n) {
      const int cl = wc * 16 * NTW + n * 16 + l15;
#pragma unroll
      for (int j = 0; j < 4; ++j) tl[(wr * 64 + m * 16 + quad * 4 + j) * LDT + cl] = f2bf(acc[m][n][j]);
    }
  __syncthreads();
  tile_store<BN>(smem, C, ldc, row0, n0);
  __syncthreads();
}

DEVI void phase_gemm_plain128(const bf* A, int lda, const bf* Wt, int K, int N, bf* C, int ldc, char* smem) {
  const int ntn = N / 128;
  for (int v = blockIdx.x; v < 128 * ntn; v += gridDim.x) {
    int m2, nt;
    lat_tile_map256(v, ntn, m2, nt);
    plain_tile256(A, lda, Wt, K, C, ldc, lat_row0_256(m2), nt * 128, smem);
  }
  const int nc = N / 32;
  for (int u = blockIdx.x; u < 4 * nc; u += gridDim.x) plain_tile<1>(A, lda, Wt, K, C, ldc, ctx_row0(u & 3), (u >> 2) * 32, smem);
}

DEVI void glu_tile(const P& p, long row0, int nt, char* smem) {
  const int tid = get_tid(), lane = tid & 63, w = tid >> 6, wr = w >> 1, wc = w & 1, l15 = lane & 15, quad = lane >> 4;
  f32x4 acc[4][2];
  zero_acc<2>(acc);
  gemm_core2<2>(acc, p.gbuf + row0 * 256, 256, p.WGLU + (long)nt * 64 * 256, 256, 256, smem);
#pragma unroll
  for (int m = 0; m < 4; ++m)
#pragma unroll
    for (int n = 0; n < 2; ++n) {
      const int col = nt * 64 + wc * 32 + n * 16 + l15;
#pragma unroll
      for (int j = 0; j < 4; ++j) {
        const long row = row0 + wr * 64 + m * 16 + quad * 4 + j;
        float g = bf2f(p.gbuf[row * 256 + col]);
        p.BR[row * DM + col] = f2bf(g * sigm(acc[m][n][j]));
      }
    }
}
DEVI void phase_glu(const P& p, char* smem) {
  for (int v = blockIdx.x; v < 256 * 4; v += gridDim.x) {
    int mtl, nt;
    lat_tile_map(v, 4, mtl, nt);
    glu_tile(p, lat_row0(mtl), nt, smem);
  }
  for (int u = blockIdx.x; u < 16; u += gridDim.x) glu_tile(p, ctx_row0(u & 3), u >> 2, smem);
}

template <int NTW>
DEVI void merge_tile(const P& p, long row0, int n0, char* smem) {
  const int tid = get_tid(), lane = tid & 63, w = tid >> 6, wr = w >> 1, wc = w & 1, l15 = lane & 15, quad = lane >> 4;
  constexpr int BN = 32 * NTW, LDT = BN + 8;
  f32x4 accM[4][NTW];
  zero_acc<NTW>(accM);
#pragma unroll 1
  for (int i = 0; i < 4; ++i) {
    unsigned pg[4][NTW][2];
    {
      f32x4 accT[4][NTW];
      zero_acc<NTW>(accT);
      gemm_core2<NTW, true>(accT, p.H + row0 * DM, DM, p.WIN + ((long)2400 + i * 1024 + n0) * 1024, 1024, 1024, smem);
#pragma unroll
      for (int m = 0; m < 4; ++m)
#pragma unroll
        for (int n = 0; n < NTW; ++n) {
          pg[m][n][0] = pack2(sigm(accT[m][n][0]), sigm(accT[m][n][1]));
          pg[m][n][1] = pack2(sigm(accT[m][n][2]), sigm(accT[m][n][3]));
        }
    }
    f32x4 accT[4][NTW];
    zero_acc<NTW>(accT);
    gemm_core2<NTW, true, true>(accT, p.BR + row0 * DM + i * 256, DM, p.WB + ((long)i * 1024 + n0) * 256, 256, 256, smem);
#pragma unroll
    for (int m = 0; m < 4; ++m)
#pragma unroll
      for (int n = 0; n < NTW; ++n) {
        accM[m][n][0] += __uint_as_float(pg[m][n][0] << 16) * accT[m][n][0];
        accM[m][n][1] += __uint_as_float(pg[m][n][0] & 0xffff0000u) * accT[m][n][1];
        accM[m][n][2] += __uint_as_float(pg[m][n][1] << 16) * accT[m][n][2];
        accM[m][n][3] += __uint_as_float(pg[m][n][1] & 0xffff0000u) * accT[m][n][3];
      }
  }
  bf* tl = reinterpret_cast<bf*>(smem);
#pragma unroll
  for (int m = 0; m < 4; ++m)
#pragma unroll
    for (int n = 0; n < NTW; ++n) {
      const int cl = wc * 16 * NTW + n * 16 + l15;
#pragma unroll
      for (int j = 0; j < 4; ++j) tl[(wr * 64 + m * 16 + quad * 4 + j) * LDT + cl] = f2bf(accM[m][n][j]);
    }
  __syncthreads();
  tile_store<BN>(smem, p.UZ, DM, row0, n0);
  __syncthreads();
}
DEVI void phase_merge(const P& p, char* smem) {
  for (int v = blockIdx.x; v < 256 * 8; v += gridDim.x) {
    int mtl, nt;
    lat_tile_map(v, 8, mtl, nt);
    merge_tile<4>(p, lat_row0(mtl), nt * 128, smem);
  }
  for (int u = blockIdx.x; u < 64; u += gridDim.x) merge_tile<2>(p, ctx_row0(u & 3), (u >> 2) * 64, smem);
}

DEVI void mla_q_tile(const P& p, int mt, int h, char* smem) {
  const int tid = get_tid(), lane = tid & 63, w = tid >> 6, wr = w >> 1, wc = w & 1, l15 = lane & 15, quad = lane >> 4;
  float* rowss = reinterpret_cast<float*>(smem + 2 * (128 * 144 + 128 * 144));
  rowss = reinterpret_cast<float*>(smem);
  f32x4 acc[4][4];
  zero_acc<4>(acc);
  gemm_core<4, true>(acc, p.UZ + (long)mt * 128 * ZLD + 256, ZLD, p.WUQ + (long)h * 128 * 192, 192, 192, smem, rowss);
  const float SC = 0.10206207261596575f * LOG2E;
  const int b = (mt * 128) / RB;
#pragma unroll
  for (int m = 0; m < 4; ++m) {
#pragma unroll
    for (int j = 0; j < 4; ++j) {
      const int rl = wr * 64 + m * 16 + quad * 4 + j;
      const int r = mt * 128 + rl;
      const int jj = r - b * RB;
      const float rs = rsqrtf(rowss[rl] * (1.f / 192.f) + EPS) * SC;
      bf* qrow = p.Qb + ((long)(b * 4 + h) * RB + jj) * 96;
      if (wc == 0) {
#pragma unroll
        for (int n = 0; n < 4; ++n) qrow[n * 16 + l15] = f2bf(acc[m][n][j] * rs);
      } else {
        const bool lat = jj >= CTXL;
        const int t = jj - CTXL;
        const float inv = ex2(-(float)(l15 & 7) * (L2_10000 / 8.f));
#pragma unroll
        for (int pr = 0; pr < 2; ++pr) {
          float xr = acc[m][2 * pr][j] * rs, xt = acc[m][2 * pr + 1][j] * rs;
          float o = xr;
          if (lat) {
            float pos = (pr == 0) ? (float)(t >> 6) : (float)(t & 63);
            float th = pos * inv;
            o = xr * __cosf(th) + xt * __sinf(th);
          }
          qrow[64 + pr * 16 + l15] = f2bf(o);
        }
      }
    }
  }
  __syncthreads();
}

DEVI void mla_kv_tile(const P& p, int mt, int h, char* smem) {
  const int tid = get_tid(), lane = tid & 63, w = tid >> 6, wr = w >> 1, wc = w & 1, l15 = lane & 15, quad = lane >> 4;
  float* rowss = reinterpret_cast<float*>(smem);
  f32x4 acc[4][4];
  zero_acc<4>(acc);
  gemm_core<4, true>(acc, p.UZ + (long)mt * 128 * ZLD + 448, ZLD, p.WUKV + (long)h * 128 * 128, 128, 128, smem, rowss);
  const int b = (mt * 128) / RB;
#pragma unroll
  for (int m = 0; m < 4; ++m) {
    const int rl0 = wr * 64 + m * 16 + quad * 4;
    const int jj0 = mt * 128 + rl0 - b * RB;
    float rs[4];
#pragma unroll
    for (int j = 0; j < 4; ++j) rs[j] = rsqrtf(rowss[rl0 + j] * (1.f / 128.f) + EPS);
    if (wc == 0) {
#pragma unroll
      for (int j = 0; j < 4; ++j) {
        bf* krow = p.Kb + ((long)(b * 4 + h) * RB + jj0 + j) * 96;
#pragma unroll
        for (int n = 0; n < 4; ++n) krow[n * 16 + l15] = f2bf(acc[m][n][j] * rs[j]);
      }
    } else {
#pragma unroll
      for (int n = 0; n < 4; ++n) {
        const int cdv = n * 16 + l15;
        u32x2 o;
        o[0] = pack2(acc[m][n][0] * rs[0], acc[m][n][1] * rs[1]);
        o[1] = pack2(acc[m][n][2] * rs[2], acc[m][n][3] * rs[3]);
        *reinterpret_cast<u32x2*>(p.Vtb + ((long)(b * 4 + h) * 64 + cdv) * RB + jj0) = o;
      }
    }
  }
  __syncthreads();
}

DEVI void rowprep_item(const P& p, int l, int it, char* smem) {
  const int tid = get_tid(), lane = tid & 63, w = tid >> 6;
  bf* vt = reinterpret_cast<bf*>(smem);
  const int r0 = it * 64;
  const int b = r0 / RB;
  const int j0 = r0 - b * RB;
  const float qn = p.qn_gqa[l * 64 + lane], kn = p.kn_gqa[l * 64 + lane];
  const float inv64 = ex2(-(float)(lane & 15) * (L2_10000 / 16.f));
  const float inv32 = ex2(-(float)(lane & 7) * (L2_10000 / 8.f));
  const float QS = 0.125f * LOG2E;
  for (int rr = 0; rr < 16; ++rr) {
    const int rl = w * 16 + rr;
    const int jj = j0 + rl;
    const bf* zr = p.UZ + (long)(r0 + rl) * ZLD;
    const bool lat = jj >= CTXL;
    const int t = jj - CTXL;
    const float prow = (float)(t >> 6), pcol = (float)(t & 63);
    float cs64 = 1.f, sn64 = 0.f, cs32 = 1.f, sn32 = 0.f;
    if (lat) {
      float th = ((lane >> 5) ? pcol : prow) * inv64;
      cs64 = __cosf(th); sn64 = __sinf(th);
      float th2 = (((lane >> 4) & 1) ? pcol : prow) * inv32;
      cs32 = __cosf(th2); sn32 = __sinf(th2);
    }
#pragma unroll
    for (int h = 0; h < 4; ++h) {
      float v = bf2f(zr[1888 + h * 64 + lane]);
      float ss = wave_sum(v * v);
      float y = v * rsqrtf(ss * (1.f / 64.f) + EPS) * qn;
      float pt = __shfl_xor(y, 16);
      float rot = (lane & 16) ? pt : -pt;
      float o = y * cs64 + rot * sn64;
      p.Qd[((long)(b * 4 + h) * RB + jj) * 64 + lane] = f2bf(o * QS);
    }
#pragma unroll
    for (int hk = 0; hk < 2; ++hk) {
      float v = bf2f(zr[2144 + hk * 64 + lane]);
      float ss = wave_sum(v * v);
      float y = v * rsqrtf(ss * (1.f / 64.f) + EPS) * kn;
      float pt = __shfl_xor(y, 16);
      float rot = (lane & 16) ? pt : -pt;
      float o = y * cs64 + rot * sn64;
      p.Kd[((long)(b * 2 + hk) * RB + jj) * 64 + lane] = f2bf(o);
    }
    {
      float v = bf2f(zr[576 + (lane & 31)]);
      float pt = __shfl_xor(v, 8);
      float rot = (lane & 8) ? pt : -pt;
      float o = v * cs32 + rot * sn32;
      if (lane < 32) {
        bf ob = f2bf(o);
#pragma unroll
        for (int h = 0; h < 4; ++h) p.Kb[((long)(b * 4 + h) * RB + jj) * 96 + 64 + lane] = ob;
      }
    }
    {
      unsigned u = *reinterpret_cast<const unsigned*>(zr + 2272 + lane * 2);
      vt[rl * 130 + lane * 2] = (bf)(u & 0xffffu);
      vt[rl * 130 + lane * 2 + 1] = (bf)(u >> 16);
    }
  }
  __syncthreads();
  {
    const int cidx = tid >> 1, half = tid & 1;
    bf* dst = p.VdT + ((long)(b * 2 + (cidx >> 6)) * 64 + (cidx & 63)) * RB + j0 + half * 32;
#pragma unroll
    for (int q = 0; q < 4; ++q) {
      u32x4 o;
#pragma unroll
      for (int e = 0; e < 4; ++e) {
        int ra = half * 32 + q * 8 + e * 2;
        o[e] = (unsigned)vt[ra * 130 + cidx] | ((unsigned)vt[(ra + 1) * 130 + cidx] << 16);
      }
      *reinterpret_cast<u32x4*>(dst + q * 8) = o;
    }
  }
  __syncthreads();
}

DEVI int s5_rc(int d, int ci) { return d == 0 ? ci : (ci < 2 ? 1 - ci : 131 - ci); }

DEVI void s5_bfrags(const P& p, int ldg, int l15, int quad, bf16x8 (&bfu)[8]) {
#pragma unroll
  for (int nt = 0; nt < 8; ++nt) {
    const int pp = (nt * 16 + l15) >> 1;
    const float* src = (l15 & 1) ? p.s5Bim : p.s5Bre;
    u32x4 wv = {0u, 0u, 0u, 0u};
    if (quad < 2) {
#pragma unroll
      for (int e = 0; e < 4; ++e) {
        const int n = quad * 8 + 2 * e;
        wv[e] = pack2(src[((long)ldg * 16 + n) * 64 + pp], src[((long)ldg * 16 + n + 1) * 64 + pp]);
      }
    }
    bfu[nt] = as_bf8(wv);
  }
}
DEVI void s5_bu_tile(const P& p, const bf16x8 (&bfu)[8], long trow0, int g, bf* XB, int l15, int quad) {
#pragma unroll
  for (int tt = 0; tt < 2; ++tt) {
    u32x4 ua = {0u, 0u, 0u, 0u};
    if (quad < 2) ua = *reinterpret_cast<const u32x4*>(p.UZ + (trow0 + tt * 16 + l15) * ZLD + g * 16 + quad * 8);
    const bf16x8 af = as_bf8(ua);
    f32x4 c[8];
#pragma unroll
    for (int nt = 0; nt < 8; ++nt) {
      c[nt] = f32x4{0.f, 0.f, 0.f, 0.f};
      c[nt] = mfma16(af, bfu[nt], c[nt]);
    }
    __builtin_amdgcn_sched_barrier(0);
    asm volatile("s_nop 7");
    asm volatile("s_nop 7");
    __builtin_amdgcn_sched_barrier(0);
#pragma unroll
    for (int nt = 0; nt < 8; ++nt)
#pragma unroll
      for (int j = 0; j < 4; ++j) XB[(tt * 16 + quad * 4 + j) * 144 + nt * 16 + l15] = f2bf(c[nt][j]);
  }
}

DEVI void s5_local_item(const P& p, int l, int it, char* smem) {
  const int tid = get_tid(), lane = tid & 63, w = tid >> 6, l15 = lane & 15, quad = lane >> 4;
  const int gq = it & 3; int t1 = it >> 2; const int ci = t1 % 130; t1 /= 130; const int d = t1 & 1, b = t1 >> 1;
  const int g = gq * 4 + w;
  const int rc = s5_rc(d, ci);
  const long row0 = (long)b * RB + rc * 128;
  bf* XB = reinterpret_cast<bf*>(smem + w * 9216);
  const int ldg = (l * 2 + d) * 16 + g;
  const float are = p.s5A[(ldg * 64 + lane) * 2], aim = p.s5A[(ldg * 64 + lane) * 2 + 1];
  bf16x8 bfu[8];
  s5_bfrags(p, ldg, l15, quad, bfu);
  float xr = 0.f, xi = 0.f;
#pragma unroll 1
  for (int sc = 0; sc < 4; ++sc) {
    const int sub = d ? 3 - sc : sc;
    s5_bu_tile(p, bfu, row0 + sub * 32, g, XB, l15, quad);
    __syncthreads();
#pragma unroll 4
    for (int s = 0; s < 32; ++s) {
      const int t = d ? 31 - s : s;
      const unsigned w2 = *reinterpret_cast<const unsigned*>(XB + t * 144 + 2 * lane);
      const float br = __uint_as_float(w2 << 16), bi = __uint_as_float(w2 & 0xffff0000u);
      const float nr = are * xr - aim * xi + br;
      const float ni = are * xi + aim * xr + bi;
      xr = nr; xi = ni;
    }
    __syncthreads();
  }
  float* e = p.s5E + ((((long)(b * 2 + d) * 130 + ci) * 16 + g) * 64 + lane) * 2;
  e[0] = xr; e[1] = xi;
}

DEVI void s5_scan_item(const P& p, int l, int it) {
  const int idx = it * 256 + get_tid();
  const int pp = idx & 63, g = (idx >> 6) & 15, d = (idx >> 10) & 1, b = idx >> 11;
  const int ldg = (l * 2 + d) * 16 + g;
  float ar = p.s5A[(ldg * 64 + pp) * 2], ai = p.s5A[(ldg * 64 + pp) * 2 + 1];
#pragma unroll
  for (int q = 0; q < 7; ++q) { float nr = ar * ar - ai * ai, ni = 2.f * ar * ai; ar = nr; ai = ni; }
  float sr = 0.f, si = 0.f;
  const long base = ((long)(b * 2 + d) * 130) * 16 * 64 + g * 64 + pp;
#pragma unroll 13
  for (int ci = 0; ci < 130; ++ci) {
    const long o = (base + (long)ci * 1024) * 2;
    float er = p.s5E[o], ei = p.s5E[o + 1];
    p.s5Cin[o] = sr; p.s5Cin[o + 1] = si;
    float nr = ar * sr - ai * si + er, ni = ar * si + ai * sr + ei;
    sr = nr; si = ni;
  }
}

template <int DIR>
DEVI void s5_out_dir(const P& p, int l, int b, int rc, int g, long row0, bf* XB, f32x4 (&yacc)[8]) {
  const int lane = get_tid() & 63, l15 = lane & 15, quad = lane >> 4;
  const int ldg = (l * 2 + DIR) * 16 + g;
  const float are = p.s5A[(ldg * 64 + lane) * 2], aim = p.s5A[(ldg * 64 + lane) * 2 + 1];
  bf16x8 bfu[8];
  s5_bfrags(p, ldg, l15, quad, bfu);
  bf16x8 cf[4];
#pragma unroll
  for (int ks = 0; ks < 4; ++ks) {
    u32x4 wv;
#pragma unroll
    for (int e = 0; e < 4; ++e) {
      const int pp = ks * 16 + quad * 4 + e;
      float cr = p.c_re[((long)ldg * 16 + l15) * 64 + pp];
      float ci = p.c_im[((long)ldg * 16 + l15) * 64 + pp];
      wv[e] = pack2(cr, -ci);
    }
    cf[ks] = as_bf8(wv);
  }
  const int ci = s5_rc(DIR, rc);
  const float* cin = p.s5Cin + ((((long)(b * 2 + DIR) * 130 + ci) * 16 + g) * 64 + lane) * 2;
  float xr = cin[0], xi = cin[1];
#pragma unroll
  for (int sc = 0; sc < 4; ++sc) {
    const int sub = DIR ? 3 - sc : sc;
    s5_bu_tile(p, bfu, row0 + sub * 32, g, XB, l15, quad);
    __syncthreads();
#pragma unroll 4
    for (int s = 0; s < 32; ++s) {
      const int t = DIR ? 31 - s : s;
      unsigned* xp = reinterpret_cast<unsigned*>(XB + t * 144 + 2 * lane);
      const unsigned w2 = *xp;
      const float br = __uint_as_float(w2 << 16), bi = __uint_as_float(w2 & 0xffff0000u);
      const float nr = are * xr - aim * xi + br;
      const float ni = are * xi + aim * xr + bi;
      xr = nr; xi = ni;
      *xp = pack2(xr, xi);
    }
    __syncthreads();
#pragma unroll
    for (int tt = 0; tt < 2; ++tt)
#pragma unroll
      for (int ks = 0; ks < 4; ++ks) {
        bf16x8 a = *reinterpret_cast<const bf16x8*>(XB + (tt * 16 + l15) * 144 + ks * 32 + quad * 8);
        yacc[sub * 2 + tt] = mfma16(a, cf[ks], yacc[sub * 2 + tt]);
      }
    __syncthreads();
  }
}

DEVI void s5_out_item(const P& p, int l, int it, char* smem) {
  const int tid = get_tid(), lane = tid & 63, w = tid >> 6, l15 = lane & 15, quad = lane >> 4;
  const int gq = it & 3; int t1 = it >> 2; const int rc = t1 % 130; const int b = t1 / 130;
  const int g = gq * 4 + w;
  const long row0 = (long)b * RB + rc * 128;
  bf* XB = reinterpret_cast<bf*>(smem + w * 9216);
  f32x4 yacc[8];
#pragma unroll
  for (int i = 0; i < 8; ++i) yacc[i] = f32x4{0.f, 0.f, 0.f, 0.f};
  s5_out_dir<0>(p, l, b, rc, g, row0, XB, yacc);
  s5_out_dir<1>(p, l, b, rc, g, row0, XB, yacc);
  const float dsk = p.s5d[l * 256 + g * 16 + l15];
#pragma unroll
  for (int tt = 0; tt < 8; ++tt)
#pragma unroll
    for (int j = 0; j < 4; ++j) {
      const long row = row0 + tt * 16 + quad * 4 + j;
      float u = bf2f(p.UZ[row * ZLD + g * 16 + l15]);
      float y = yacc[tt][j] + dsk * u;
      p.gbuf[row * 256 + g * 16 + l15] = f2bf(gelu_tanh(y));
    }
}


DEVI void ld16(const bf* p, float (&o)[16]) {
  u32x4 a = *reinterpret_cast<const u32x4*>(p), b = *reinterpret_cast<const u32x4*>(p + 8);
#pragma unroll
  for (int e = 0; e < 4; ++e) {
    o[2 * e] = __uint_as_float(a[e] << 16); o[2 * e + 1] = __uint_as_float(a[e] & 0xffff0000u);
    o[8 + 2 * e] = __uint_as_float(b[e] << 16); o[8 + 2 * e + 1] = __uint_as_float(b[e] & 0xffff0000u);
  }
}
DEVI int hg_rc(int d, int ci) { return d == 0 ? ci : (ci < 4 ? 3 - ci : 263 - ci); }
DEVI float hg_lb(const P& p, int l, int d, int ch) {
  if (l == 0) return 0.f;
  float r0 = p.lb_raw[(d * 2 + 0) * 256 + ch], r1 = p.lb_raw[(d * 2 + 1) * 256 + ch];
  return fminf(fmaxf(sigm(r1 - r0), 0.f), 1.f);
}

DEVI void hgrn_cumsum(float* arr, float* segt, int d, int tid) {
  const int k = tid & 63, seg = tid >> 6;
  float v[16];
  float c = 0.f;
#pragma unroll
  for (int s = 0; s < 16; ++s) { const int q = seg * 16 + s; const int t = d ? 63 - q : q; c += arr[t * 68 + k]; v[s] = c; }
  segt[seg * 64 + k] = c;
  __syncthreads();
  float off = 0.f;
#pragma unroll
  for (int s2 = 0; s2 < 3; ++s2) if (s2 < seg) off += segt[s2 * 64 + k];
#pragma unroll
  for (int s = 0; s < 16; ++s) { const int q = seg * 16 + s; const int t = d ? 63 - q : q; arr[t * 68 + k] = v[s] + off; }
  __syncthreads();
}

DEVI void hgrn_local_item(const P& p, int l, int it, char* smem) {
  const int tid = get_tid(), lane = tid & 63, w = tid >> 6, l15 = lane & 15, quad = lane >> 4;
  const int rc = it % 260; int t1 = it / 260; const int h = t1 & 3, d = (t1 >> 2) & 1, b = t1 >> 3;
  const long row0 = (long)b * RB + rc * 64;
  float* lf = reinterpret_cast<float*>(smem);
  bf* KKt = reinterpret_cast<bf*>(smem + 17408);
  bf* Vt = reinterpret_cast<bf*>(smem + 17408 + 9216);
  float* tot = reinterpret_cast<float*>(smem + 17408 + 2 * 9216);
  const int t = tid >> 2, k0 = (tid & 3) * 16;
  const bf* zr = p.UZ + (row0 + t) * ZLD;
  float kv[16];
  {
    float zfv[16], vv[16];
    ld16(zr + 1120 + d * 256 + h * 64 + k0, zfv);
    ld16(zr + 864 + h * 64 + k0, vv);
#pragma unroll
    for (int e = 0; e < 16; ++e) {
      const int k = k0 + e;
      float zf = zfv[e];
      float lb = hg_lb(p, l, d, h * 64 + k);
      float sg = sigm(zf);
      float f = lb + (1.f - lb) * sg;
      lf[t * 68 + k] = __log2f(fmaxf(f, 1e-20f));
      kv[e] = (1.f - lb) * sigm(-zf);
      Vt[k * 72 + t] = f2bf(vv[e]);
    }
  }
  __syncthreads();
  hgrn_cumsum(lf, reinterpret_cast<float*>(smem + 36864), d, tid);
  const int tlast = d ? 0 : 63;
#pragma unroll
  for (int e = 0; e < 16; ++e) { const int k = k0 + e; KKt[k * 72 + t] = f2bf(kv[e] * ex2(lf[tlast * 68 + k] - lf[t * 68 + k])); }
  const long sbase = (((long)(b * 2 + d) * 4 + h) * 260 + rc);
  if (tid < 64) p.hD[sbase * 64 + tid] = ex2(lf[tlast * 68 + tid]);
  __syncthreads();
#pragma unroll
  for (int kt = 0; kt < 4; ++kt) {
    f32x4 acc = {0.f, 0.f, 0.f, 0.f};
#pragma unroll
    for (int ks = 0; ks < 2; ++ks) {
      bf16x8 a = *reinterpret_cast<const bf16x8*>(Vt + (w * 16 + l15) * 72 + ks * 32 + quad * 8);
      bf16x8 bb = *reinterpret_cast<const bf16x8*>(KKt + (kt * 16 + l15) * 72 + ks * 32 + quad * 8);
      acc = mfma16(a, bb, acc);
    }
#pragma unroll
    for (int j = 0; j < 4; ++j) p.hS[(sbase * 64 + w * 16 + quad * 4 + j) * 64 + kt * 16 + l15] = f2bf(acc[j]);
  }
  __syncthreads();
}

DEVI void hgrn_scan_item(const P& p, int it) {
  const int seq = it >> 4;
  const int d = (seq >> 2) & 1;
  const int el = (it & 15) * 256 + get_tid();
  const int k = el & 63;
  float s = 0.f;
  const long sb = (long)seq * 260;
#pragma unroll 20
  for (int ci = 0; ci < 260; ++ci) {
    const int rc = hg_rc(d, ci);
    const long o = (sb + rc) * 4096 + el;
    float loc = bf2f(p.hS[o]);
    float dk = p.hD[(sb + rc) * 64 + k];
    p.hS[o] = f2bf(s);
    s = dk * s + loc;
  }
}

DEVI void hgrn_out_item(const P& p, int l, int it, char* smem) {
  const int tid = get_tid(), lane = tid & 63, w = tid >> 6, l15 = lane & 15, quad = lane >> 4;
  const int rc = it % 260; const int t1 = it / 260; const int h = t1 & 3, b = t1 >> 2;
  const long row0 = (long)b * RB + rc * 64;
  float* cum = reinterpret_cast<float*>(smem);
  bf* qb = reinterpret_cast<bf*>(smem + 17408);
  bf* kvb = reinterpret_cast<bf*>(smem + 26624);
  bf* Stb = reinterpret_cast<bf*>(smem + 35840);
  bf* Vtb = reinterpret_cast<bf*>(smem + 45056);
  bf* attb = reinterpret_cast<bf*>(smem + 54272);
  f32x4 oacc[4];
#pragma unroll
  for (int i = 0; i < 4; ++i) oacc[i] = f32x4{0.f, 0.f, 0.f, 0.f};
  const int t = tid >> 2, k0 = (tid & 3) * 16;
  const bf* zr = p.UZ + (row0 + t) * ZLD;
#pragma unroll 1
  for (int d = 0; d < 2; ++d) {
    {
      float zfv[16], vv[16];
      ld16(zr + 1120 + d * 256 + h * 64 + k0, zfv);
      ld16(zr + 864 + h * 64 + k0, vv);
      const u32x4 q0 = *reinterpret_cast<const u32x4*>(zr + 608 + h * 64 + k0), q1 = *reinterpret_cast<const u32x4*>(zr + 608 + h * 64 + k0 + 8);
      *reinterpret_cast<u32x4*>(qb + t * 72 + k0) = q0;
      *reinterpret_cast<u32x4*>(qb + t * 72 + k0 + 8) = q1;
#pragma unroll
      for (int e = 0; e < 16; ++e) {
        const int k = k0 + e;
        float zf = zfv[e];
        float lb = hg_lb(p, l, d, h * 64 + k);
        float f = lb + (1.f - lb) * sigm(zf);
        cum[t * 68 + k] = __log2f(fmaxf(f, 1e-20f));
        kvb[t * 72 + k] = f2bf((1.f - lb) * sigm(-zf));
        Vtb[k * 72 + t] = f2bf(vv[e]);
      }
    }
    {
      const long sbase = (((long)(b * 2 + d) * 4 + h) * 260 + rc) * 4096;
      const bf* sp = p.hS + sbase + t * 64 + k0;
      u32x4 s0 = *reinterpret_cast<const u32x4*>(sp), s1 = *reinterpret_cast<const u32x4*>(sp + 8);
      *reinterpret_cast<u32x4*>(Stb + t * 72 + k0) = s0;
      *reinterpret_cast<u32x4*>(Stb + t * 72 + k0 + 8) = s1;
    }
    __syncthreads();
    hgrn_cumsum(cum, reinterpret_cast<float*>(smem + 72704), d, tid);
    {
      {
        const int jq = t >> 4;
#pragma unroll
        for (int e = 0; e < 16; ++e) {
          const int k = k0 + e;
          float r;
          if (d == 0) r = (jq > 0) ? cum[(16 * jq - 1) * 68 + k] : 0.f;
          else r = (jq < 3) ? cum[(16 * jq + 16) * 68 + k] : 0.f;
          kvb[t * 72 + k] = f2bf(bf2f(kvb[t * 72 + k]) * ex2(fminf(r - cum[t * 68 + k], 100.f)));
        }
      }
      __syncthreads();
      bf* qs = reinterpret_cast<bf*>(smem + 63488) + w * 1152;
      const int tq = 16 * w + (lane >> 2), kq0 = (lane & 3) * 16;
#pragma unroll 1
      for (int jg = 0; jg < 4; ++jg) {
        const bool gv = d == 0 ? (jg <= w) : (jg >= w);
        if (gv) {
#pragma unroll
          for (int e = 0; e < 16; ++e) {
            const int k = kq0 + e;
            float r;
            if (d == 0) r = (jg > 0) ? cum[(16 * jg - 1) * 68 + k] : 0.f;
            else r = (jg < 3) ? cum[(16 * jg + 16) * 68 + k] : 0.f;
            qs[(lane >> 2) * 72 + k] = f2bf(bf2f(qb[tq * 72 + k]) * ex2(cum[tq * 68 + k] - r));
          }
        }
        __syncthreads();
        if (gv) {
          f32x4 ac = {0.f, 0.f, 0.f, 0.f};
#pragma unroll
          for (int ks = 0; ks < 2; ++ks) {
            bf16x8 a1 = *reinterpret_cast<const bf16x8*>(qs + l15 * 72 + ks * 32 + quad * 8);
            bf16x8 b1 = *reinterpret_cast<const bf16x8*>(kvb + (16 * jg + l15) * 72 + ks * 32 + quad * 8);
            ac = mfma16(a1, b1, ac);
          }
#pragma unroll
          for (int j = 0; j < 4; ++j) {
            const int ta = 16 * w + quad * 4 + j, sg = 16 * jg + l15;
            const bool ok = d == 0 ? (sg <= ta) : (sg >= ta);
            attb[ta * 72 + sg] = f2bf(ok ? ac[j] : 0.f);
          }
        } else {
#pragma unroll
          for (int j = 0; j < 4; ++j) attb[(16 * w + quad * 4 + j) * 72 + 16 * jg + l15] = 0;
        }
        __syncthreads();
      }
    }
#pragma unroll
    for (int e = 0; e < 16; ++e) { const int k = k0 + e; kvb[t * 72 + k] = f2bf(bf2f(qb[t * 72 + k]) * ex2(cum[t * 68 + k])); }
    __syncthreads();
#pragma unroll
    for (int vt = 0; vt < 4; ++vt)
#pragma unroll
      for (int ks = 0; ks < 2; ++ks) {
        bf16x8 a1 = *reinterpret_cast<const bf16x8*>(kvb + (w * 16 + l15) * 72 + ks * 32 + quad * 8);
        bf16x8 b1 = *reinterpret_cast<const bf16x8*>(Stb + (vt * 16 + l15) * 72 + ks * 32 + quad * 8);
        oacc[vt] = mfma16(a1, b1, oacc[vt]);
        bf16x8 a2 = *reinterpret_cast<const bf16x8*>(attb + (w * 16 + l15) * 72 + ks * 32 + quad * 8);
        bf16x8 b2 = *reinterpret_cast<const bf16x8*>(Vtb + (vt * 16 + l15) * 72 + ks * 32 + quad * 8);
        oacc[vt] = mfma16(a2, b2, oacc[vt]);
      }
    __syncthreads();
  }
#pragma unroll
  for (int j = 0; j < 4; ++j) {
    float ss = 0.f;
#pragma unroll
    for (int vt = 0; vt < 4; ++vt) ss += oacc[vt][j] * oacc[vt][j];
    ss += __shfl_xor(ss, 1); ss += __shfl_xor(ss, 2); ss += __shfl_xor(ss, 4); ss += __shfl_xor(ss, 8);
    const float rs = rsqrtf(ss * (1.f / 64.f) + EPS);
    const long row = row0 + w * 16 + quad * 4 + j;
#pragma unroll
    for (int vt = 0; vt < 4; ++vt) {
      const int c = vt * 16 + l15;
      float gt = bf2f(p.UZ[row * ZLD + 1632 + h * 64 + c]);
      float o = oacc[vt][j] * rs * p.onorm[l * 64 + c] * silu_(gt);
      p.BR[row * DM + 512 + h * 64 + c] = f2bf(o);
    }
  }
}

template <int DK>
DEVI void attn_tile(const char* kb, const char* vb, const bool first, const bf16x8 (&qf)[2][DK / 32], f32x4 (&o)[2][4],
                    float (&mrun)[2], float (&lsum)[2], const int l15, const int quad) {
  constexpr int KSTR = (DK == 64) ? 160 : 224;
  constexpr int NKK = DK / 32;
  f32x4 s[2][4];
#pragma unroll
  for (int qt = 0; qt < 2; ++qt)
#pragma unroll
    for (int ks = 0; ks < 4; ++ks) { const float nm = -mrun[qt]; s[qt][ks] = f32x4{nm, nm, nm, nm}; }
#pragma unroll
  for (int ks = 0; ks < 4; ++ks)
#pragma unroll
    for (int kk = 0; kk < NKK; ++kk) {
      bf16x8 kf = *reinterpret_cast<const bf16x8*>(kb + (ks * 16 + l15) * KSTR + (kk * 32 + quad * 8) * 2);
      s[0][ks] = mfma16(kf, qf[0][kk], s[0][ks]);
      s[1][ks] = mfma16(kf, qf[1][kk], s[1][ks]);
    }
  bf16x8 pf[2][2];
#pragma unroll
  for (int qt = 0; qt < 2; ++qt) {
    float mx = fmaxf(fmaxf(s[qt][0][0], s[qt][0][1]), fmaxf(s[qt][0][2], s[qt][0][3]));
#pragma unroll
    for (int ks = 1; ks < 4; ++ks) mx = fmaxf(mx, fmaxf(fmaxf(s[qt][ks][0], s[qt][ks][1]), fmaxf(s[qt][ks][2], s[qt][ks][3])));
    if (__any(first || (mx > 8.f))) {
      float rm = fmaxf(mx, __shfl_xor(mx, 16));
      rm = fmaxf(rm, __shfl_xor(rm, 32));
      const float delta = first ? rm : fmaxf(rm, 0.f);
      const float alpha = first ? 1.f : ex2(-delta);
      mrun[qt] += delta;
      lsum[qt] *= alpha;
#pragma unroll
      for (int ks = 0; ks < 4; ++ks)
#pragma unroll
        for (int j = 0; j < 4; ++j) s[qt][ks][j] -= delta;
#pragma unroll
      for (int dd = 0; dd < 4; ++dd)
#pragma unroll
        for (int j = 0; j < 4; ++j) o[qt][dd][j] *= alpha;
    }
    float ps = 0.f;
#pragma unroll
    for (int ks = 0; ks < 4; ++ks)
#pragma unroll
      for (int j = 0; j < 4; ++j) { float pv = ex2(s[qt][ks][j]); s[qt][ks][j] = pv; ps += pv; }
    lsum[qt] += ps;
#pragma unroll
    for (int k2 = 0; k2 < 2; ++k2) {
      u32x4 wv;
      wv[0] = pack2(s[qt][2 * k2][0], s[qt][2 * k2][1]);
      wv[1] = pack2(s[qt][2 * k2][2], s[qt][2 * k2][3]);
      wv[2] = pack2(s[qt][2 * k2 + 1][0], s[qt][2 * k2 + 1][1]);
      wv[3] = pack2(s[qt][2 * k2 + 1][2], s[qt][2 * k2 + 1][3]);
      pf[qt][k2] = as_bf8(wv);
    }
  }
#pragma unroll
  for (int dd = 0; dd < 4; ++dd)
#pragma unroll
    for (int k2 = 0; k2 < 2; ++k2) {
      u32x2 lo = *reinterpret_cast<const u32x2*>(vb + (dd * 16 + l15) * 144 + (k2 * 32 + quad * 4) * 2);
      u32x2 hi = *reinterpret_cast<const u32x2*>(vb + (dd * 16 + l15) * 144 + (k2 * 32 + 16 + quad * 4) * 2);
      u32x4 vv = {lo[0], lo[1], hi[0], hi[1]};
      bf16x8 vf = as_bf8(vv);
      o[0][dd] = mfma16(vf, pf[0][k2], o[0][dd]);
      o[1][dd] = mfma16(vf, pf[1][k2], o[1][dd]);
    }
}

template <int DK, int QP>
DEVI void attn_item(const bf* __restrict__ Q, const bf* __restrict__ Kp, const bf* __restrict__ Vt, bf* __restrict__ outp  ,
                    long row_base, int j0, int nkeys, char* smem) {
  constexpr int KSTR = (DK == 64) ? 160 : 224;
  constexpr int KSZ = 64 * KSTR, VSZ = 64 * 144, STG = KSZ + VSZ;
  constexpr int KCH = DK / 8;
  constexpr int NKL = (64 * KCH) / 256;
  constexpr int NKK = DK / 32;
  const int tid = get_tid(), lane = tid & 63, w = tid >> 6, l15 = lane & 15, quad = lane >> 4;
  bf16x8 qf[QP][2][NKK];
#pragma unroll
  for (int pr = 0; pr < QP; ++pr)
#pragma unroll
    for (int qt = 0; qt < 2; ++qt)
#pragma unroll
      for (int kk = 0; kk < NKK; ++kk)
        qf[pr][qt][kk] = *reinterpret_cast<const bf16x8*>(Q + (long)(j0 + w * (32 * QP) + pr * 32 + qt * 16 + l15) * DK + kk * 32 + quad * 8);
  f32x4 o[QP][2][4];
  float mrun[QP][2], lsum[QP][2];
#pragma unroll
  for (int pr = 0; pr < QP; ++pr)
#pragma unroll
    for (int qt = 0; qt < 2; ++qt) {
      mrun[pr][qt] = 0.f; lsum[pr][qt] = 0.f;
#pragma unroll
      for (int dd = 0; dd < 4; ++dd) o[pr][qt][dd] = f32x4{0.f, 0.f, 0.f, 0.f};
    }
  u32x4 rkA[NKL], rvA[2];
  const int nt = nkeys >> 6;
  int kr[NKL], kc[NKL];
#pragma unroll
  for (int i = 0; i < NKL; ++i) { const int c = tid + 256 * i; kr[i] = c / KCH; kc[i] = c - kr[i] * KCH; }
  const int vr = tid >> 3, vc = tid & 7;
#define ALOAD(RK, RV, T)                                                                                        \
  {                                                                                                             \
    _Pragma("unroll") for (int i = 0; i < NKL; ++i)                                                             \
      RK[i] = *reinterpret_cast<const u32x4*>(Kp + (long)((T)*64 + kr[i]) * DK + kc[i] * 8);                    \
    _Pragma("unroll") for (int i = 0; i < 2; ++i)                                                               \
      RV[i] = *reinterpret_cast<const u32x4*>(Vt + (long)(vr + 32 * i) * RB + (T)*64 + vc * 8);                 \
  }
#define AWRITE(RK, RV, S)                                                                                       \
  {                                                                                                             \
    _Pragma("unroll") for (int i = 0; i < NKL; ++i)                                                             \
      *reinterpret_cast<u32x4*>(smem + (S)*STG + kr[i] * KSTR + kc[i] * 16) = RK[i];                            \
    _Pragma("unroll") for (int i = 0; i < 2; ++i)                                                               \
      *reinterpret_cast<u32x4*>(smem + (S)*STG + KSZ + (vr + 32 * i) * 144 + vc * 16) = RV[i];                  \
  }
  ALOAD(rkA, rvA, 0);
  AWRITE(rkA, rvA, 0);
  __syncthreads();
  for (int t = 0; t < nt; ++t) {
    ALOAD(rkA, rvA, min(t + 1, nt - 1));
    const char* kb = smem + (t & 1) * STG;
#pragma unroll
    for (int pr = 0; pr < QP; ++pr) {
      attn_tile<DK>(kb, kb + KSZ, t == 0, qf[pr], o[pr], mrun[pr], lsum[pr], l15, quad);
      if (QP > 1) __builtin_amdgcn_sched_barrier(0);
    }
    AWRITE(rkA, rvA, (t + 1) & 1);
    __syncthreads();
  }
#undef ALOAD
#undef AWRITE
#pragma unroll
  for (int pr = 0; pr < QP; ++pr)
#pragma unroll
    for (int qt = 0; qt < 2; ++qt) {
      float ls = lsum[pr][qt];
      ls += __shfl_xor(ls, 16);
      ls += __shfl_xor(ls, 32);
      const float inv = 1.f / ls;
      const long row = row_base + j0 + w * (32 * QP) + pr * 32 + qt * 16 + l15;
#pragma unroll
      for (int dd = 0; dd < 4; ++dd) {
        u32x2 ov;
        ov[0] = pack2(o[pr][qt][dd][0] * inv, o[pr][qt][dd][1] * inv);
        ov[1] = pack2(o[pr][qt][dd][2] * inv, o[pr][qt][dd][3] * inv);
        *reinterpret_cast<u32x2*>(outp + row * DM + dd * 16 + quad * 4) = ov;
      }
    }
}

DEVI void attn_dispatch(const P& p, int it, char* smem) {
  if (it < 1024 || (it >= 1536 && it < 1552)) {
    int b, h, j0, nkeys;
    if (it < 1024) { const int pr = it & 7; b = pr >> 2; h = pr & 3; j0 = CTXL + (it >> 3) * 128; nkeys = RB; }
    else { const int c = it - 1536; b = c >> 3; h = (c >> 1) & 3; j0 = (c & 1) * 128; nkeys = CTXL; }
    attn_item<96, 1>(p.Qb + (long)(b * 4 + h) * RB * 96, p.Kb + (long)(b * 4 + h) * RB * 96, p.Vtb + (long)(b * 4 + h) * 64 * RB,
                     p.BR + 256 + h * 64, (long)b * RB, j0, nkeys, smem);
  } else {
    int b, h, j0, nkeys;
    if (it < 1536) { const int r = it - 1024; const int pr = r & 7; b = pr >> 2; h = pr & 3; j0 = CTXL + (r >> 3) * 256; nkeys = RB; }
    else { const int c = it - 1552; b = c >> 2; h = c & 3; j0 = 0; nkeys = CTXL; }
    const int hk = h >> 1;
    attn_item<64, 2>(p.Qd + (long)(b * 4 + h) * RB * 64, p.Kd + (long)(b * 2 + hk) * RB * 64, p.VdT + (long)(b * 2 + hk) * 64 * RB,
                     p.BR + 768 + h * 64, (long)b * RB, j0, nkeys, smem);
  }
}


#include <vector>

#define XB_TMO      128
#define XB_XCNT(j)  (256  + 64 * (j))
#define XB_XSUB(j)  (1280 + 64 * (j))
#define XB_XGEN(j)  (2304 + 64 * (j))
#define XB_TOP      3328
#define XB_TOPGEN   3392
#define XCD_BAR_WORDS 3456
#define XB_SPIN_CAP (1u << 18)
#define LAS __attribute__((address_space(3)))

__device__ __forceinline__ unsigned xb_ld(unsigned* p)              { return __hip_atomic_load(p, __ATOMIC_RELAXED, __HIP_MEMORY_SCOPE_AGENT); }
__device__ __forceinline__ unsigned xb_add(unsigned* p, unsigned v) { return __hip_atomic_fetch_add(p, v, __ATOMIC_RELAXED, __HIP_MEMORY_SCOPE_AGENT); }
__device__ __forceinline__ unsigned xb_xcc_id() { return (unsigned)__builtin_amdgcn_s_getreg((3 << 11) | 20) & 0xFu; }
#define XB_SPIN(cond, bar) do { unsigned _sp = 0; while (cond) { __builtin_amdgcn_s_sleep(1); \
    if ((++_sp & 255u) == 0u) { if (xb_ld(&(bar)[XB_TMO])) break; if (_sp > XB_SPIN_CAP) { atomicAdd(&(bar)[XB_TMO], 1u); break; } } } } while (0)

struct XcdBarrier {
    unsigned* bar; unsigned x;
    volatile LAS unsigned* st;
};

__device__ __forceinline__ XcdBarrier xcd_barrier_post(unsigned* bar, volatile LAS unsigned* st) {
    XcdBarrier b; b.bar = bar; b.x = xb_xcc_id(); b.st = st;
    if (threadIdx.x == 0) (void)xb_add(&bar[XB_XCNT(b.x)], 1u);
    return b;
}
__device__ __forceinline__ void xcd_barrier_complete(unsigned* bar, unsigned x, unsigned& nloc, unsigned& nx) {
    const unsigned G = gridDim.x * gridDim.y * gridDim.z;
    unsigned sum, cnt, mine, sp = 0u;
    for (;;) {
        sum = 0u; cnt = 0u; mine = 0u;
#pragma unroll
        for (unsigned j = 0; j < 16; ++j) { const unsigned c = xb_ld(&bar[XB_XCNT(j)]); sum += c; cnt += (c > 0u) ? 1u : 0u; mine = (j == x) ? c : mine; }
        if (sum == G) break;
        __builtin_amdgcn_s_sleep(1);
        if ((++sp & 255u) == 0u) { if (xb_ld(&bar[XB_TMO])) break; if (sp > XB_SPIN_CAP) { atomicAdd(&bar[XB_TMO], 1u); break; } }
    }
    nloc = mine > 0u ? mine : 1u; nx = cnt > 0u ? cnt : 1u;
}

__device__ __forceinline__ void xcd_barrier(const XcdBarrier& b) {
    asm volatile("s_waitcnt vmcnt(0)" ::: "memory");
    __syncthreads();
    if (threadIdx.x == 0) {
        unsigned* bar = b.bar;
        __builtin_amdgcn_s_waitcnt(0);
        unsigned nloc = b.st[0], nx = b.st[1];
        if (nloc == 0u) { xcd_barrier_complete(bar, b.x, nloc, nx); b.st[0] = nloc; b.st[1] = nx; }
        const unsigned old = xb_add(&bar[XB_XSUB(b.x)], 1u);
        const unsigned gen = old / nloc;
        if (old + 1u == (gen + 1u) * nloc) {
            __builtin_amdgcn_fence(__ATOMIC_RELEASE, "agent");
            asm volatile("s_waitcnt vmcnt(0)" ::: "memory");
            const unsigned og = xb_add(&bar[XB_TOP], 1u);
            const unsigned tg = og / nx;
            if (og + 1u == (tg + 1u) * nx) xb_add(&bar[XB_TOPGEN], 1u);
            else XB_SPIN(xb_ld(&bar[XB_TOPGEN]) == tg, bar);
            __builtin_amdgcn_fence(__ATOMIC_ACQUIRE, "agent");
            xb_add(&bar[XB_XGEN(b.x)], 1u);
            asm volatile("s_waitcnt vmcnt(0)" ::: "memory");
        } else {
            XB_SPIN(xb_ld(&bar[XB_XGEN(b.x)]) == gen, bar);
            __builtin_amdgcn_fence(__ATOMIC_ACQUIRE, "agent");
            asm volatile("s_waitcnt vmcnt(0)" ::: "memory");
        }
    }
    __syncthreads();
}

DEVI void gbar(unsigned* ctr, unsigned target) {
  asm volatile("s_waitcnt vmcnt(0)" ::: "memory");
  __syncthreads();
  if (threadIdx.x == 0) {
    __builtin_amdgcn_fence(__ATOMIC_RELEASE, "agent");
    asm volatile("s_waitcnt vmcnt(0)" ::: "memory");
    __hip_atomic_fetch_add(ctr, 1u, __ATOMIC_RELAXED, __HIP_MEMORY_SCOPE_AGENT);
    while (__hip_atomic_load(ctr, __ATOMIC_RELAXED, __HIP_MEMORY_SCOPE_AGENT) < target) __builtin_amdgcn_s_sleep(1);
    __builtin_amdgcn_fence(__ATOMIC_ACQUIRE, "agent");
    asm volatile("s_waitcnt vmcnt(0)" ::: "memory");
  }
  __syncthreads();
}

constexpr int NPHASE = 32;

DEVI void run_phase(const P& p, int ph, char* smem) {
  const int nb = gridDim.x, b0 = blockIdx.x;
  if (ph == 0) {
    const int total = CONV_ITEMS + 288 + 16;
    for (int it = b0; it < total; it += nb) {
      if (it < 288) mods_item(p, it, smem);
      else if (it < 304) s5disc_item(p, it - 288);
      else {
        const int cnt[13] = {1408, 1408, 704, 704, 102 * 16, 64, 64, 64, 64, 256, 16, 24, 16};
        int job = 0, r = it - 304;
#pragma unroll
        for (int j = 0; j < 13; ++j) { if (job == j && r >= cnt[j]) { r -= cnt[j]; job = j + 1; } }
        conv_tile(p, 0, job, r, smem);
      }
    }
    return;
  }
  if (ph == 1) {
    phase_rowpass(p, true, false, 0.f, p.mod, 0, p.norm_post, true, p.mod, 0, p.norm_pre);
    return;
  }
  const int l = (ph - 2) / 15, q = (ph - 2) % 15;
  const float* modl = p.mod + (long)l * 3 * 9216;
  switch (q) {
    case 0:
      if (l == 1) phase_conv(p, 1, smem, b0, nb);
      break;
    case 1: phase_ffn1(p, 0, smem); break;
    case 2: phase_gemm_plain128(p.UZ, DFF, p.W2, DFF, 1024, p.Y, DM, smem); break;
    case 3:
      phase_rowpass(p, l == 0, true, 0.5f, modl, 2, p.norm_post + (l * 3 + 0) * DM, true, modl, 3, p.norm_pre + (l * 3 + 1) * DM);
      break;
    case 4: phase_gemm_plain128(p.H, DM, p.WIN, 1024, ZLD, p.UZ, ZLD, smem); break;
    case 5: {
      for (int it = b0; it < 8840; it += nb) {
        if (it < 1040) mla_q_tile(p, it >> 2, it & 3, smem);
        else if (it < 2080) mla_kv_tile(p, (it - 1040) >> 2, (it - 1040) & 3, smem);
        else if (it < 2600) rowprep_item(p, l, it - 2080, smem);
        else if (it < 4680) s5_local_item(p, l, it - 2600, smem);
        else hgrn_local_item(p, l, it - 4680, smem);
      }
    } break;
    case 6: {
      for (int it = b0; it < 256 + 16 + 1560; it += nb) {
        if (it < 256) hgrn_scan_item(p, it);
        else if (it < 272) s5_scan_item(p, l, it - 256);
        else attn_dispatch(p, it - 272, smem);
      }
    } break;
    case 7: {
      for (int it = b0; it < 1040 + 2080; it += nb) {
        if (it < 1040) s5_out_item(p, l, it, smem);
        else hgrn_out_item(p, l, it - 1040, smem);
        __syncthreads();
      }
    } break;
    case 8: phase_glu(p, smem); break;
    case 9: phase_merge(p, smem); break;
    case 10: phase_gemm_plain128(p.UZ, DM, p.WOUT, 1024, 1024, p.Y, DM, smem); break;
    case 11:
      phase_rowpass(p, false, true, 1.0f, modl, 5, p.norm_post + (l * 3 + 1) * DM, true, modl, 6, p.norm_pre + (l * 3 + 2) * DM);
      break;
    case 12: phase_ffn1(p, 1, smem); break;
    case 13: phase_gemm_plain128(p.UZ, DFF, p.W2 + (long)1024 * DFF, DFF, 1024, p.Y, DM, smem); break;
    case 14:
      phase_rowpass(p, false, true, 0.5f, modl, 8, p.norm_post + (l * 3 + 2) * DM, l == 0, p.mod + (long)3 * 9216, 0, p.norm_pre + (3 + 0) * DM);
      break;
  }
}

__global__ void __launch_bounds__(256, 2) fwd_kernel(P p, int ph_begin, int ph_end) {
  __shared__ __attribute__((aligned(16))) char smem[SMEM_BYTES];
  if (ph_end - ph_begin == 1) {
    run_phase(p, ph_begin, smem);
    return;
  }
  cg::grid_group grid = cg::this_grid();
  __shared__ uint4 xb_words;
  if (threadIdx.x == 0) xb_words = make_uint4(0u, 0u, 0u, 0u);
  __syncthreads();
  XcdBarrier xb = xcd_barrier_post(p.bar, (volatile LAS unsigned*)&xb_words);
  for (int ph = ph_begin; ph < ph_end; ++ph) {
    if (ph == 2) continue;
    run_phase(p, ph, smem);
    if (ph + 1 < ph_end) {
      if (ph_end < 0) grid.sync();
      xcd_barrier(xb);
    }
  }
}

extern "C" void kernel_launch(void* const* d_in, const int* in_sizes, int n_in, void* d_out, int out_size, void* d_ws, size_t ws_size,
                              hipStream_t stream) {
  P p{};
  const float** pp = reinterpret_cast<const float**>(&p);
  for (int i = 0; i < 31; ++i) pp[i] = (const float*)d_in[i];
  p.out = (float*)d_out;
  char* ws = (char*)d_ws;
  size_t off = 0;
  auto take = [&](size_t bytes) { char* r = ws + off; off += (bytes + 255) & ~(size_t)255; return r; };
  p.W13 = (bf*)take((size_t)2 * 5632 * 1024 * 2);
  p.W2 = (bf*)take((size_t)2 * 1024 * DFF * 2);
  p.WIN = (bf*)take((size_t)NIN * 1024 * 2);
  p.WB = (bf*)take((size_t)4 * 1024 * 256 * 2);
  p.WOUT = (bf*)take((size_t)1024 * 1024 * 2);
  p.WGLU = (bf*)take((size_t)256 * 256 * 2);
  p.WUQ = (bf*)take((size_t)512 * 192 * 2);
  p.WUKV = (bf*)take((size_t)512 * 128 * 2);
  p.H = (bf*)take((size_t)NR * 1024 * 2);
  p.UZ = (bf*)take((size_t)NR * DFF * 2);
  {
    char* y = take((size_t)NR * 1024 * 2);
    p.Y = (bf*)y;
    p.hS = (bf*)y;
    p.Qd = (bf*)(y + 34078720);
    p.Kd = (bf*)(y + 34078720 + 17039360);
    p.VdT = (bf*)(y + 34078720 + 17039360 + 8519680);
  }
  {
    char* q = take((size_t)NR * 1024 * 2);
    p.Qb = (bf*)q;
    p.Kb = (bf*)(q + 25559040);
    p.Vtb = (bf*)(q + 2 * 25559040);
    p.gbuf = (bf*)q;
  }
  p.BR = (bf*)take((size_t)NR * 1024 * 2);
  p.xctx = (float*)take((size_t)512 * 1024 * 4);
  p.mod = (float*)take((size_t)2 * 3 * 9216 * 4);
  p.s5A = (float*)take((size_t)2 * 2 * 16 * 64 * 2 * 4);
  p.s5Bre = (float*)take((size_t)2 * 2 * 16 * 16 * 64 * 4);
  p.s5Bim = (float*)take((size_t)2 * 2 * 16 * 16 * 64 * 4);
  p.s5E = (float*)take((size_t)2 * 2 * 130 * 1024 * 8);
  p.s5Cin = (float*)take((size_t)2 * 2 * 130 * 1024 * 8);
  p.hD = (float*)take((size_t)2 * 2 * 4 * 260 * 64 * 4);
  p.bar = (unsigned*)take(XCD_BAR_WORDS * 4);
  if (off > ws_size) { fprintf(stderr, "kernel_launch: workspace too small: need %zu have %zu\n", off, ws_size); return; }

  static int grid_blocks = 0;
  if (!grid_blocks) {
    int dev = 0, cus = 0, per_cu = 0;
    hipGetDevice(&dev);
    hipDeviceGetAttribute(&cus, hipDeviceAttributeMultiprocessorCount, dev);
    hipOccupancyMaxActiveBlocksPerMultiprocessor(&per_cu, fwd_kernel, 256, 0);
    if (per_cu > 2) per_cu = 2;
    if (per_cu < 1) per_cu = 1;
    grid_blocks = cus * per_cu;
  }
#if MULTI_LAUNCH
  for (int ph = 0; ph < NPHASE; ++ph) {
    if (ph == 2) continue;
    hipLaunchKernelGGL(fwd_kernel, dim3(grid_blocks), dim3(256), 0, stream, p, ph, ph + 1);
  }
#else
  hipMemsetAsync(p.bar, 0, XCD_BAR_WORDS * 4, stream);
  int b = 0, e = NPHASE;
  void* args[] = {&p, &b, &e};
  hipError_t err = hipLaunchCooperativeKernel((void*)fwd_kernel, dim3(grid_blocks), dim3(256), args, 0, stream);
  if (err != hipSuccess) fprintf(stderr, "cooperative launch failed: %s (grid %d)\n", hipGetErrorString(err), grid_blocks);
#endif
}
```

```cpp
#include <hip/hip_runtime.h>
#include <hip/hip_cooperative_groups.h>
#include <cstdio>
namespace cg = cooperative_groups;

#ifndef MULTI_LAUNCH
#define MULTI_LAUNCH 0
#endif

typedef unsigned short bf;
typedef __attribute__((ext_vector_type(8))) short bf16x8;
typedef __attribute__((ext_vector_type(4))) float f32x4;
typedef __attribute__((ext_vector_type(4))) unsigned int u32x4;
typedef __attribute__((ext_vector_type(2))) unsigned int u32x2;

#define DEVI __device__ __forceinline__

constexpr int DM = 1024, RB = 16640, NR = 33280, CTXL = 256, SEQL = 16384, DFF = 2816, NIN = 6496, ZLD = 2432;
constexpr float EPS = 1e-6f;
constexpr float LOG2E = 1.4426950408889634f;
constexpr float L2_10000 = 13.287712379549449f;
constexpr int SMEM_BYTES = 73728;

struct P {
  const float *x, *c, *ctx, *c_ctx, *w_ada, *b_ada, *norm_pre, *norm_post, *w1, *w3, *w2, *w_in,
      *lam_re, *lam_im, *log_dt, *b_re, *b_im, *c_re, *c_im, *s5d, *wglu, *qn_mla, *wuq, *kvn_mla, *wukv,
      *lb_raw, *onorm, *qn_gqa, *kn_gqa, *wbr, *wout;
  float* out;
  bf *W13, *W2, *WIN, *WB, *WOUT, *WGLU, *WUQ, *WUKV;
  bf *H, *UZ, *Y, *BR;
  bf *hS, *Qd, *Kd, *VdT, *Qb, *Kb, *Vtb, *gbuf;
  float *xctx, *mod, *s5A, *s5Bre, *s5Bim, *s5E, *s5Cin, *hD;
  unsigned* bar;
};

typedef __bf16 bf16x2_t __attribute__((ext_vector_type(2)));
typedef float f32x2_t __attribute__((ext_vector_type(2)));
DEVI bf f2bf(float f) { __bf16 r = (__bf16)f; return *reinterpret_cast<bf*>(&r); }
DEVI float bf2f(bf h) { return __uint_as_float(((unsigned)h) << 16); }
DEVI unsigned pack2(float a, float b) { f32x2_t v = {a, b}; bf16x2_t r = __builtin_convertvector(v, bf16x2_t); return *reinterpret_cast<unsigned*>(&r); }
DEVI float sigm(float x) { return 1.f / (1.f + __expf(-x)); }
DEVI float silu_(float x) { return x / (1.f + __expf(-x)); }
DEVI float gelu_tanh(float x) {
  float u = 0.7978845608028654f * (x + 0.044715f * x * x * x);
  float t = 1.f - 2.f / (1.f + __expf(2.f * u));
  return 0.5f * x * (1.f + t);
}
DEVI float ex2(float x) { return __builtin_amdgcn_exp2f(x); }
DEVI float wave_sum(float v) {
#pragma unroll
  for (int o = 32; o > 0; o >>= 1) v += __shfl_xor(v, o);
  return v;
}
DEVI int get_tid() { int t = threadIdx.x; asm volatile("" : "+v"(t)); return t; }
DEVI f32x4 mfma16(bf16x8 a, bf16x8 b, f32x4 c) { return __builtin_amdgcn_mfma_f32_16x16x32_bf16(a, b, c, 0, 0, 0); }
DEVI bf16x8 as_bf8(u32x4 v) { return *reinterpret_cast<bf16x8*>(&v); }

DEVI bool tile_map(int v, int ntn, int& mt, int& nt) {
  const int x = v & 7, idx = v >> 3;
  const int cm = (260 - x + 7) >> 3;
  const int full = 32 * ntn;
  int ml;
  if (idx < full) {
    const int per = 8 * ntn;
    const int gi = idx / per, within = idx - gi * per;
    nt = within >> 3;
    ml = gi * 8 + (within & 7);
  } else {
    const int k = idx - full;
    const int gs = cm - 32;
    if (k >= gs * ntn) return false;
    nt = k / gs;
    ml = 32 + (k - nt * gs);
  }
  mt = x + 8 * ml;
  return true;
}
constexpr int TILE_V(int ntn) { return 8 * 33 * ntn; }

template <int NTW, bool ROWSS>
DEVI void gemm_core(f32x4 (&acc)[4][NTW], const bf* __restrict__ A, int lda, const bf* __restrict__ Bt, int ldb, int K,
                    char* smem, float* rowss) {
  constexpr int BN = 32 * NTW;
  constexpr int ASZ = 128 * 144;
  constexpr int BSZ = BN * 144;
  constexpr int STG = ASZ + BSZ;
  constexpr int NBL = BN / 32;
  const int tid = get_tid(), lane = tid & 63, w = tid >> 6, wr = w >> 1, wc = w & 1, l15 = lane & 15, quad = lane >> 4;
  const int lr = tid >> 3, lc = (tid & 7) * 8;
  u32x4 ra[4], rb[NBL];
  float ss[4] = {0.f, 0.f, 0.f, 0.f};
  const int nk = K >> 6;
#pragma unroll
  for (int i = 0; i < 4; ++i) ra[i] = *reinterpret_cast<const u32x4*>(A + (long)(lr + 32 * i) * lda + lc);
#pragma unroll
  for (int i = 0; i < NBL; ++i) rb[i] = *reinterpret_cast<const u32x4*>(Bt + (long)(lr + 32 * i) * ldb + lc);
  {
#pragma unroll
    for (int i = 0; i < 4; ++i) *reinterpret_cast<u32x4*>(smem + (lr + 32 * i) * 144 + lc * 2) = ra[i];
#pragma unroll
    for (int i = 0; i < NBL; ++i) *reinterpret_cast<u32x4*>(smem + ASZ + (lr + 32 * i) * 144 + lc * 2) = rb[i];
    if (ROWSS) {
#pragma unroll
      for (int i = 0; i < 4; ++i)
#pragma unroll
        for (int e = 0; e < 4; ++e) {
          unsigned u = ra[i][e];
          float lo = __uint_as_float(u << 16), hi = __uint_as_float(u & 0xffff0000u);
          ss[i] += lo * lo + hi * hi;
        }
    }
  }
  __syncthreads();
  for (int kt = 0; kt < nk; ++kt) {
    const bool more = (kt + 1 < nk);
    if (more) {
      const int k0 = (kt + 1) * 64;
#pragma unroll
      for (int i = 0; i < 4; ++i) ra[i] = *reinterpret_cast<const u32x4*>(A + (long)(lr + 32 * i) * lda + k0 + lc);
#pragma unroll
      for (int i = 0; i < NBL; ++i) rb[i] = *reinterpret_cast<const u32x4*>(Bt + (long)(lr + 32 * i) * ldb + k0 + lc);
    }
    const char* base = smem + (kt & 1) * STG;
#pragma unroll
    for (int ks = 0; ks < 2; ++ks) {
      bf16x8 af[4], bfr[NTW];
#pragma unroll
      for (int m = 0; m < 4; ++m)
        af[m] = *reinterpret_cast<const bf16x8*>(base + (wr * 64 + m * 16 + l15) * 144 + (ks * 32 + quad * 8) * 2);
#pragma unroll
      for (int n = 0; n < NTW; ++n)
        bfr[n] = *reinterpret_cast<const bf16x8*>(base + ASZ + (wc * 16 * NTW + n * 16 + l15) * 144 + (ks * 32 + quad * 8) * 2);
#pragma unroll
      for (int m = 0; m < 4; ++m)
#pragma unroll
        for (int n = 0; n < NTW; ++n) acc[m][n] = mfma16(af[m], bfr[n], acc[m][n]);
    }
    if (more) {
      char* nb = smem + ((kt + 1) & 1) * STG;
#pragma unroll
      for (int i = 0; i < 4; ++i) *reinterpret_cast<u32x4*>(nb + (lr + 32 * i) * 144 + lc * 2) = ra[i];
#pragma unroll
      for (int i = 0; i < NBL; ++i) *reinterpret_cast<u32x4*>(nb + ASZ + (lr + 32 * i) * 144 + lc * 2) = rb[i];
      if (ROWSS) {
#pragma unroll
        for (int i = 0; i < 4; ++i)
#pragma unroll
          for (int e = 0; e < 4; ++e) {
            unsigned u = ra[i][e];
            float lo = __uint_as_float(u << 16), hi = __uint_as_float(u & 0xffff0000u);
            ss[i] += lo * lo + hi * hi;
          }
      }
    }
    __syncthreads();
  }
  if (ROWSS) {
#pragma unroll
    for (int i = 0; i < 4; ++i) {
      float s = ss[i];
      s += __shfl_xor(s, 1); s += __shfl_xor(s, 2); s += __shfl_xor(s, 4);
      if ((tid & 7) == 0) rowss[lr + 32 * i] = s;
    }
    __syncthreads();
  }
}


DEVI void glds16(const bf* g, char* l) {
  __builtin_amdgcn_global_load_lds((const unsigned*)g, (__attribute__((address_space(3))) unsigned*)l, 16, 0, 0);
}

template <int NTW, bool SPLIT = false, bool HALFA = false>
DEVI void gemm_core2(f32x4 (&acc)[4][NTW], const bf* __restrict__ A, int lda, const bf* __restrict__ Bt, int ldb, int K, char* smem) {
  constexpr int BN = 32 * NTW;
  constexpr int ASZ = 128 * 128;
  constexpr int BSZ = BN * 128;
  constexpr int STG = ASZ + BSZ;
  constexpr int NBL = BN / 32;
  const int tid = get_tid(), lane = tid & 63, w = tid >> 6, wr = w >> 1, wc = w & 1, l15 = lane & 15, quad = lane >> 4;
  const int lr = tid >> 3, pch = tid & 7;
  const int lch = pch ^ (lr & 7);
  const int nk = K >> 6;
  const bf* Ap = A + (long)lr * lda + lch * 8;
  const bf* Bp = Bt + (long)lr * ldb + lch * 8;
  const long sa = (long)32 * lda, sb = (long)32 * ldb;
  char* dbase = smem + tid * 16;
  const int sw0 = ((quad ^ (l15 & 7)) << 4), sw1 = (((4 + quad) ^ (l15 & 7)) << 4);
  const char* abase = smem + (wr * 64 + l15) * 128;
  const char* bbase = smem + ASZ + (wc * 16 * NTW + l15) * 128;
#pragma unroll
  for (int i = 0; i < 4; ++i) glds16(Ap + i * sa, dbase + i * 4096);
#pragma unroll
  for (int i = 0; i < NBL; ++i) glds16(Bp + i * sb, dbase + ASZ + i * 4096);
  __syncthreads();
  const int klast = K - 64;
  for (int kt = 0; kt < nk; ++kt) {
    const int k1 = min((kt + 1) * 64, klast);
    const int so = (kt & 1) * STG, sn = ((kt + 1) & 1) * STG;
    if (!SPLIT) {
      bf16x8 af[2][4], bfr[2][NTW];
#pragma unroll
      for (int ks = 0; ks < 2; ++ks) {
        const int swz = ks ? sw1 : sw0;
#pragma unroll
        for (int m = 0; m < 4; ++m) af[ks][m] = *reinterpret_cast<const bf16x8*>(abase + so + m * 16 * 128 + swz);
#pragma unroll
        for (int n = 0; n < NTW; ++n) bfr[ks][n] = *reinterpret_cast<const bf16x8*>(bbase + so + n * 16 * 128 + swz);
      }
#pragma unroll
      for (int i = 0; i < 4; ++i) glds16(Ap + i * sa + k1, dbase + sn + i * 4096);
#pragma unroll
      for (int i = 0; i < NBL; ++i) glds16(Bp + i * sb + k1, dbase + sn + ASZ + i * 4096);
      __builtin_amdgcn_s_setprio(1);
#pragma unroll
      for (int ks = 0; ks < 2; ++ks)
#pragma unroll
        for (int m = 0; m < 4; ++m)
#pragma unroll
          for (int n = 0; n < NTW; ++n) acc[m][n] = mfma16(af[ks][m], bfr[ks][n], acc[m][n]);
    } else {
      if (HALFA) {
#pragma unroll
        for (int ks = 0; ks < 2; ++ks) {
          const int swz = ks ? sw1 : sw0;
          bf16x8 bfr[NTW];
#pragma unroll
          for (int n = 0; n < NTW; ++n) bfr[n] = *reinterpret_cast<const bf16x8*>(bbase + so + n * 16 * 128 + swz);
#pragma unroll
          for (int mh = 0; mh < 2; ++mh) {
            bf16x8 af[2];
#pragma unroll
            for (int m = 0; m < 2; ++m) af[m] = *reinterpret_cast<const bf16x8*>(abase + so + (mh * 2 + m) * 16 * 128 + swz);
            if (ks == 1 && mh == 1) {
#pragma unroll
              for (int i = 0; i < 4; ++i) glds16(Ap + i * sa + k1, dbase + sn + i * 4096);
#pragma unroll
              for (int i = 0; i < NBL; ++i) glds16(Bp + i * sb + k1, dbase + sn + ASZ + i * 4096);
            }
#pragma unroll
            for (int m = 0; m < 2; ++m)
#pragma unroll
              for (int n = 0; n < NTW; ++n) acc[mh * 2 + m][n] = mfma16(af[m], bfr[n], acc[mh * 2 + m][n]);
          }
        }
      } else
#pragma unroll
      for (int ks = 0; ks < 2; ++ks) {
        const int swz = ks ? sw1 : sw0;
        bf16x8 af[4], bfr[NTW];
#pragma unroll
        for (int m = 0; m < 4; ++m) af[m] = *reinterpret_cast<const bf16x8*>(abase + so + m * 16 * 128 + swz);
#pragma unroll
        for (int n = 0; n < NTW; ++n) bfr[n] = *reinterpret_cast<const bf16x8*>(bbase + so + n * 16 * 128 + swz);
        if (ks == 1) {
#pragma unroll
          for (int i = 0; i < 4; ++i) glds16(Ap + i * sa + k1, dbase + sn + i * 4096);
#pragma unroll
          for (int i = 0; i < NBL; ++i) glds16(Bp + i * sb + k1, dbase + sn + ASZ + i * 4096);
        }
        __builtin_amdgcn_s_setprio(1);
#pragma unroll
        for (int m = 0; m < 4; ++m)
#pragma unroll
          for (int n = 0; n < NTW; ++n) acc[m][n] = mfma16(af[m], bfr[n], acc[m][n]);
        __builtin_amdgcn_s_setprio(0);
      }
    }
    __builtin_amdgcn_s_setprio(0);
    __syncthreads();
  }
}

DEVI void gemm_core3(f32x4 (&acc)[8][4], const bf* __restrict__ A, int lda, const bf* __restrict__ Bt, int ldb, int K, char* smem) {
  constexpr int ASZ = 256 * 64, BSZ = 128 * 64, STG = ASZ + BSZ;
  const int tid = get_tid(), lane = tid & 63, w = tid >> 6, wr = w >> 1, wc = w & 1, l15 = lane & 15, quad = lane >> 4;
  const int lr = tid >> 2, ch = tid & 3;
  const int nk = K >> 5;
  const int lch = ch ^ (((lr >> 3) & 1) << 1);
  const bf* Ap = A + (long)lr * lda + lch * 8;
  const bf* Bp = Bt + (long)lr * ldb + lch * 8;
  const long sa = (long)64 * lda, sb = (long)64 * ldb;
  char* dbase = smem + tid * 16;
  const int rsw = (quad ^ (((l15 >> 3) & 1) << 1)) << 4;
  const char* abase = smem + (wr * 128 + l15) * 64 + rsw;
  const char* bbase = smem + ASZ + (wc * 64 + l15) * 64 + rsw;
#pragma unroll
  for (int i = 0; i < 4; ++i) glds16(Ap + i * sa, dbase + i * 4096);
#pragma unroll
  for (int i = 0; i < 2; ++i) glds16(Bp + i * sb, dbase + ASZ + i * 4096);
  __syncthreads();
  const int klast = K - 32;
  for (int kt = 0; kt < nk; ++kt) {
    const int k1 = min((kt + 1) * 32, klast);
    const int sn = ((kt + 1) & 1) * STG;
    const int so = (kt & 1) * STG;
    bf16x8 bfr[4], af[8];
#pragma unroll
    for (int n = 0; n < 4; ++n) bfr[n] = *reinterpret_cast<const bf16x8*>(bbase + so + n * 16 * 64);
#pragma unroll
    for (int m = 0; m < 8; ++m) af[m] = *reinterpret_cast<const bf16x8*>(abase + so + m * 16 * 64);
#pragma unroll
    for (int i = 0; i < 4; ++i) glds16(Ap + i * sa + k1, dbase + sn + i * 4096);
#pragma unroll
    for (int i = 0; i < 2; ++i) glds16(Bp + i * sb + k1, dbase + sn + ASZ + i * 4096);
    __builtin_amdgcn_s_setprio(1);
#pragma unroll
    for (int m = 0; m < 8; ++m)
#pragma unroll
      for (int n = 0; n < 4; ++n) acc[m][n] = mfma16(af[m], bfr[n], acc[m][n]);
    __builtin_amdgcn_s_setprio(0);
    __syncthreads();
  }
}
template <int BN>
DEVI void tile_store256(const char* smem, bf* __restrict__ C, long ldc, long row0, int col0) {
  constexpr int LDT = BN + 8;
  constexpr int CPR = BN / 8;
  const int tid = get_tid();
#pragma unroll
  for (int i = 0; i < CPR; ++i) {
    const int q = tid + 256 * i;
    const int r = q / CPR, c = q - r * CPR;
    u32x4 v = *reinterpret_cast<const u32x4*>(smem + (r * LDT + c * 8) * 2);
    *reinterpret_cast<u32x4*>(C + (row0 + r) * ldc + col0 + c * 8) = v;
  }
}
DEVI long lat_row0_256(int m2) { return m2 < 64 ? (long)CTXL + (long)m2 * 256 : (long)RB + CTXL + (long)(m2 - 64) * 256; }
DEVI void lat_tile_map256(int v, int ntn, int& m2, int& nt) {
  const int x = v & 7, idx = v >> 3;
  const int per = 8 * ntn;
  const int gi = idx / per, within = idx - gi * per;
  nt = within >> 3;
  m2 = x + 8 * (gi * 8 + (within & 7));
}

template <int NTW>
DEVI void zero_acc(f32x4 (&acc)[4][NTW]) {
#pragma unroll
  for (int m = 0; m < 4; ++m)
#pragma unroll
    for (int n = 0; n < NTW; ++n) acc[m][n] = f32x4{0.f, 0.f, 0.f, 0.f};
}


template <int BN>
DEVI void tile_store(const char* smem, bf* __restrict__ C, long ldc, long row0, int col0) {
  constexpr int LDT = BN + 8;
  const int tid = get_tid();
  const int r = tid >> 1, half = tid & 1;
#pragma unroll
  for (int c = 0; c < BN / 16; ++c) {
    u32x4 v = *reinterpret_cast<const u32x4*>(smem + (r * LDT + half * (BN / 2) + c * 8) * 2);
    *reinterpret_cast<u32x4*>(C + (row0 + r) * ldc + col0 + half * (BN / 2) + c * 8) = v;
  }
}

DEVI void conv_tile(const P& p, int l, int job, int tile, char* smem) {
  float* tl = reinterpret_cast<float*>(smem);
  const int tid = get_tid();
  int Np, K, ld;
  const float* src = nullptr; const float* src2 = nullptr; const float* gv = nullptr; bf* dst = nullptr;
  if (job < 2) { Np = 5632; K = 1024; ld = DFF; src = p.w1 + (long)(l * 2 + job) * DM * DFF; src2 = p.w3 + (long)(l * 2 + job) * DM * DFF; dst = p.W13 + (long)job * 5632 * 1024; }
  else if (job < 4) { Np = 1024; K = DFF; ld = DM; src = p.w2 + (long)(l * 2 + job - 2) * DFF * DM; dst = p.W2 + (long)(job - 2) * 1024 * DFF; }
  else if (job == 4) { Np = NIN; K = 1024; ld = NIN; src = p.w_in + (long)l * DM * NIN; dst = p.WIN; }
  else if (job < 9) { Np = 1024; K = 256; ld = DM; src = p.wbr + (long)(l * 4 + job - 5) * 256 * DM; dst = p.WB + (long)(job - 5) * 1024 * 256; }
  else if (job == 9) { Np = 1024; K = 1024; ld = DM; src = p.wout + (long)l * DM * DM; dst = p.WOUT; }
  else if (job == 10) { Np = 256; K = 256; ld = 256; src = p.wglu + (long)l * 256 * 256; dst = p.WGLU; }
  else if (job == 11) { Np = 512; K = 192; ld = 384; src = p.wuq + (long)l * 192 * 384; gv = p.qn_mla + l * 192; dst = p.WUQ; }
  else { Np = 512; K = 128; ld = 512; src = p.wukv + (long)l * 128 * 512; gv = p.kvn_mla + l * 128; dst = p.WUKV; }
  const int nkt = K >> 6;
  const int tn = tile / nkt, tk = tile - tn * nkt;
  const int n0 = tn * 64, k0 = tk * 64;
  {
    const int kk = tid >> 2, seg = (tid & 3) * 16;
    const int k = k0 + kk;
    const float gs = gv ? gv[k] : 1.f;
    if (job != 11) {
      const int np0 = n0 + seg;
      f32x4 q4[4];
#pragma unroll
      for (int c = 0; c < 4; ++c) q4[c] = f32x4{0.f, 0.f, 0.f, 0.f};
      if (np0 < Np) {
        const float* sp;
        if (job < 2) sp = (((np0 >> 4) & 1) ? src2 : src) + (long)k * ld + 16 * (np0 >> 5);
        else sp = src + (long)k * ld + np0;
#pragma unroll
        for (int c = 0; c < 4; ++c) q4[c] = *reinterpret_cast<const f32x4*>(sp + 4 * c);
      }
#pragma unroll
      for (int c = 0; c < 4; ++c)
#pragma unroll
        for (int e = 0; e < 4; ++e) tl[kk * 65 + seg + 4 * c + e] = q4[c][e] * gs;
    } else
#pragma unroll 4
    for (int e = 0; e < 16; ++e) {
      const int np = n0 + seg + e;
      float val = 0.f;
      if (np < Np) {
        if (job < 2) {
          int cidx = 16 * (np >> 5) + (np & 15);
          int s = (np >> 4) & 1;
          val = (s ? src2 : src)[(long)k * ld + cidx];
        } else if (job == 11) {
          int h = np >> 7, cp = np & 127;
          if (cp < 64) val = src[(long)k * ld + h * 96 + cp];
          else {
            int c2 = cp - 64, blk = c2 >> 4, e2 = c2 & 15;
            int rho = (blk >> 1) * 16 + e2;
            if (blk & 1) {
              if ((rho & 8) == 0) val = -src[(long)k * ld + h * 96 + 64 + rho + 8];
              else val = src[(long)k * ld + h * 96 + 64 + rho - 8];
            } else val = src[(long)k * ld + h * 96 + 64 + rho];
          }
          val *= gs;
        } else {
          val = src[(long)k * ld + np] * gs;
        }
      }
      tl[kk * 65 + seg + e] = val;
    }
  }
  __syncthreads();
  {
    const int n = tid >> 2, ksg = (tid & 3) * 16;
    if (n0 + n < Np) {
      u32x4 o0, o1;
#pragma unroll
      for (int e = 0; e < 4; ++e) {
        o0[e] = pack2(tl[(ksg + 2 * e) * 65 + n], tl[(ksg + 2 * e + 1) * 65 + n]);
        o1[e] = pack2(tl[(ksg + 8 + 2 * e) * 65 + n], tl[(ksg + 8 + 2 * e + 1) * 65 + n]);
      }
      bf* d = dst + (long)(n0 + n) * K + k0 + ksg;
      *reinterpret_cast<u32x4*>(d) = o0;
      *reinterpret_cast<u32x4*>(d + 8) = o1;
    }
  }
  __syncthreads();
}

DEVI void phase_conv(const P& p, int l, char* smem, int item0, int nblk) {
  const int cnt[13] = {1408, 1408, 704, 704, 102 * 16, 64, 64, 64, 64, 256, 16, 24, 16};
  int total = 0;
#pragma unroll
  for (int j = 0; j < 13; ++j) total += cnt[j];
  for (int it = item0; it < total; it += nblk) {
    int job = 0, r = it;
#pragma unroll
    for (int j = 0; j < 13; ++j) { if (job == j && r >= cnt[j]) { r -= cnt[j]; job = j + 1; } }
    conv_tile(p, l, job, r, smem);
  }
}
constexpr int CONV_ITEMS = 1408 * 2 + 704 * 2 + 102 * 16 + 64 * 4 + 256 + 16 + 24 + 16;

DEVI void mods_item(const P& p, int it, char* smem) {
  const int l = it / 144, cb = it % 144;
  float* sc = reinterpret_cast<float*>(smem);
  float* part = sc + 3 * 1024;
  const int tid = get_tid(), lane = tid & 63, w = tid >> 6;
  for (int i = tid; i < 3 * 1024; i += 256) {
    int g = i >> 10, k = i & 1023;
    float v = (g < 2) ? p.c[g * 1024 + k] : p.c_ctx[k];
    sc[i] = silu_(v);
  }
  __syncthreads();
  const int col = cb * 64 + lane;
  const float* wp = p.w_ada + ((long)l * 1024 + w * 256) * 9216 + col;
  float a0 = 0.f, a1 = 0.f, a2 = 0.f;
#pragma unroll 32
  for (int k = 0; k < 256; ++k) {
    float wv = wp[(long)k * 9216];
    a0 += sc[w * 256 + k] * wv; a1 += sc[1024 + w * 256 + k] * wv; a2 += sc[2048 + w * 256 + k] * wv;
  }
  part[(w * 3 + 0) * 64 + lane] = a0; part[(w * 3 + 1) * 64 + lane] = a1; part[(w * 3 + 2) * 64 + lane] = a2;
  __syncthreads();
  if (tid < 192) {
    int g = tid >> 6, ln = tid & 63;
    float s = part[(0 * 3 + g) * 64 + ln] + part[(1 * 3 + g) * 64 + ln] + part[(2 * 3 + g) * 64 + ln] + part[(3 * 3 + g) * 64 + ln];
    int cc = cb * 64 + ln;
    p.mod[((long)(l * 3 + g)) * 9216 + cc] = s + p.b_ada[l * 9216 + cc];
  }
  __syncthreads();
}

DEVI void s5disc_item(const P& p, int it) {
  const int idx = it * 256 + get_tid();
  const int pp = idx & 63, g = (idx >> 6) & 15, d = (idx >> 10) & 1, l = idx >> 11;
  const int ldg = (l * 2 + d) * 16 + g;
  float lre = fminf(p.lam_re[ldg * 64 + pp], -1e-4f);
  float lim = p.lam_im[ldg * 64 + pp];
  float dt = expf(p.log_dt[ldg]);
  float mag = expf(lre * dt);
  float are = mag * cosf(lim * dt), aim = mag * sinf(lim * dt);
  float den = lre * lre + lim * lim;
  float nre = are - 1.f;
  float fre = (nre * lre + aim * lim) / den;
  float fim = (aim * lre - nre * lim) / den;
  p.s5A[(ldg * 64 + pp) * 2] = are; p.s5A[(ldg * 64 + pp) * 2 + 1] = aim;
#pragma unroll 4
  for (int n = 0; n < 16; ++n) {
    float br = p.b_re[((long)ldg * 64 + pp) * 16 + n], bi = p.b_im[((long)ldg * 64 + pp) * 16 + n];
    p.s5Bre[((long)ldg * 16 + n) * 64 + pp] = fre * br - fim * bi;
    p.s5Bim[((long)ldg * 16 + n) * 64 + pp] = fre * bi + fim * br;
  }
}

DEVI void phase_rowpass(const P& p, bool first_in, bool has_y, float resw, const float* modg  , int gate_idx,
                        const float* gpost, bool has_h, const float* modh, int shift_idx, const float* gpre) {
  const int tid = get_tid(), lane = tid & 63, w = tid >> 6;
  const int gw = blockIdx.x * 4 + w, nw = gridDim.x * 4;
  int rpw = (NR + nw - 1) / nw;
  rpw += rpw & 1;
  const int r0 = gw * rpw, r1 = min(r0 + rpw, NR);
  int cur = -1;
  f32x4 gg[4], ps[4], sh[4];
#pragma unroll
  for (int i = 0; i < 4; ++i) { gg[i] = f32x4{0.f, 0.f, 0.f, 0.f}; ps[i] = gg[i]; sh[i] = gg[i]; }
  for (int r = r0; r < r1; r += 2) {
    const int b = r / RB, j = r - b * RB;
    const bool isctx = j < CTXL;
    const int grp = isctx ? 2 : b;
    if (grp != cur) {
      cur = grp;
      if (has_y) {
        const float* gt = modg + ((long)grp * 9 + gate_idx) * DM;
#pragma unroll
        for (int i = 0; i < 4; ++i) {
          f32x4 g4 = *reinterpret_cast<const f32x4*>(gt + i * 256 + lane * 4);
          f32x4 gp = *reinterpret_cast<const f32x4*>(gpost + i * 256 + lane * 4);
#pragma unroll
          for (int e = 0; e < 4; ++e) gg[i][e] = g4[e] * gp[e] * resw;
        }
      }
      if (has_h) {
        const float* shp = modh + ((long)grp * 9 + shift_idx) * DM;
        const float* scl = shp + DM;
#pragma unroll
        for (int i = 0; i < 4; ++i) {
          f32x4 c4 = *reinterpret_cast<const f32x4*>(scl + i * 256 + lane * 4);
          f32x4 gp = *reinterpret_cast<const f32x4*>(gpre + i * 256 + lane * 4);
          sh[i] = *reinterpret_cast<const f32x4*>(shp + i * 256 + lane * 4);
#pragma unroll
          for (int e = 0; e < 4; ++e) ps[i][e] = gp[e] * (1.f + c4[e]);
        }
      }
    }
    const float* xin; float* xout;
    if (isctx) { xout = p.xctx + (long)(b * CTXL + j) * DM; xin = first_in ? p.ctx + (long)(b * CTXL + j) * DM : xout; }
    else { xout = p.out + ((long)b * SEQL + (j - CTXL)) * DM; xin = first_in ? p.x + ((long)b * SEQL + (j - CTXL)) * DM : xout; }
    f32x4 xv[2][4];
    u32x2 yu[2][4];
#pragma unroll
    for (int q = 0; q < 2; ++q)
#pragma unroll
      for (int i = 0; i < 4; ++i) xv[q][i] = *reinterpret_cast<const f32x4*>(xin + q * DM + i * 256 + lane * 4);
    if (has_y) {
#pragma unroll
      for (int q = 0; q < 2; ++q)
#pragma unroll
        for (int i = 0; i < 4; ++i) yu[q][i] = *reinterpret_cast<const u32x2*>(p.Y + (long)(r + q) * DM + i * 256 + lane * 4);
#pragma unroll
      for (int q = 0; q < 2; ++q) {
        float yv[4][4];
        float ss = 0.f;
#pragma unroll
        for (int i = 0; i < 4; ++i) {
          yv[i][0] = __uint_as_float(yu[q][i][0] << 16); yv[i][1] = __uint_as_float(yu[q][i][0] & 0xffff0000u);
          yv[i][2] = __uint_as_float(yu[q][i][1] << 16); yv[i][3] = __uint_as_float(yu[q][i][1] & 0xffff0000u);
#pragma unroll
          for (int e = 0; e < 4; ++e) ss += yv[i][e] * yv[i][e];
        }
        ss = wave_sum(ss);
        const float rs = rsqrtf(ss * (1.f / DM) + EPS);
#pragma unroll
        for (int i = 0; i < 4; ++i) {
#pragma unroll
          for (int e = 0; e < 4; ++e) xv[q][i][e] += gg[i][e] * (yv[i][e] * rs);
          *reinterpret_cast<f32x4*>(xout + q * DM + i * 256 + lane * 4) = xv[q][i];
        }
      }
    }
    if (has_h) {
#pragma unroll
      for (int q = 0; q < 2; ++q) {
        float ss = 0.f;
#pragma unroll
        for (int i = 0; i < 4; ++i)
#pragma unroll
          for (int e = 0; e < 4; ++e) ss += xv[q][i][e] * xv[q][i][e];
        ss = wave_sum(ss);
        const float rs = rsqrtf(ss * (1.f / DM) + EPS);
#pragma unroll
        for (int i = 0; i < 4; ++i) {
          float h0 = xv[q][i][0] * rs * ps[i][0] + sh[i][0];
          float h1 = xv[q][i][1] * rs * ps[i][1] + sh[i][1];
          float h2 = xv[q][i][2] * rs * ps[i][2] + sh[i][2];
          float h3 = xv[q][i][3] * rs * ps[i][3] + sh[i][3];
          u32x2 o; o[0] = pack2(h0, h1); o[1] = pack2(h2, h3);
          *reinterpret_cast<u32x2*>(p.H + (long)(r + q) * DM + i * 256 + lane * 4) = o;
        }
      }
    }
  }
}

DEVI long lat_row0(int mtl) { return mtl < 128 ? (long)CTXL + (long)mtl * 128 : (long)RB + CTXL + (long)(mtl - 128) * 128; }
DEVI long ctx_row0(int c) { return (long)(c >> 1) * RB + (long)(c & 1) * 128; }
DEVI void lat_tile_map(int v, int ntn, int& mtl, int& nt) {
  const int x = v & 7, idx = v >> 3;
  const int per = 8 * ntn;
  const int gi = idx / per, within = idx - gi * per;
  nt = within >> 3;
  mtl = x + 8 * (gi * 8 + (within & 7));
}

template <int NTW>
DEVI void ffn1_tile(const P& p, const bf* W, long row0, int n0  , char* smem) {
  const int tid = get_tid(), lane = tid & 63, w = tid >> 6, wr = w >> 1, wc = w & 1, l15 = lane & 15, quad = lane >> 4;
  constexpr int OW = 16 * NTW;
  constexpr int LDT = OW + 8;
  f32x4 acc[4][NTW];
  zero_acc<NTW>(acc);
  gemm_core2<NTW>(acc, p.H + row0 * DM, DM, W + (long)n0 * 1024, 1024, 1024, smem);
  bf* tl = reinterpret_cast<bf*>(smem);
#pragma unroll
  for (int m = 0; m < 4; ++m)
#pragma unroll
    for (int pr = 0; pr < NTW / 2; ++pr) {
      const int cl = (wc * (NTW / 2) + pr) * 16 + l15;
#pragma unroll
      for (int j = 0; j < 4; ++j) {
        const int rl = wr * 64 + m * 16 + quad * 4 + j;
        float a = acc[m][2 * pr][j], b = acc[m][2 * pr + 1][j];
        tl[rl * LDT + cl] = f2bf(silu_(a) * b);
      }
    }
  __syncthreads();
  tile_store<OW>(smem, p.UZ, DFF, row0, n0 / 2);
  __syncthreads();
}


DEVI void ffn1_tile256(const P& p, const bf* W, long row0, int n0  , char* smem) {
  const int tid = get_tid(), lane = tid & 63, w = tid >> 6, wr = w >> 1, wc = w & 1, l15 = lane & 15, quad = lane >> 4;
  f32x4 acc[8][4];
#pragma unroll
  for (int m = 0; m < 8; ++m)
#pragma unroll
    for (int n = 0; n < 4; ++n) acc[m][n] = f32x4{0.f, 0.f, 0.f, 0.f};
  gemm_core3(acc, p.H + row0 * DM, DM, W + (long)n0 * 1024, 1024, 1024, smem);
  bf* tl = reinterpret_cast<bf*>(smem);
#pragma unroll
  for (int m = 0; m < 8; ++m)
#pragma unroll
    for (int pr = 0; pr < 2; ++pr) {
      const int cl = (wc * 2 + pr) * 16 + l15;
#pragma unroll
      for (int j = 0; j < 4; ++j) {
        const int rl = wr * 128 + m * 16 + quad * 4 + j;
        float a = acc[m][2 * pr][j], b = acc[m][2 * pr + 1][j];
        tl[rl * 72 + cl] = f2bf(silu_(a) * b);
      }
    }
  __syncthreads();
  tile_store256<64>(smem, p.UZ, DFF, row0, n0 / 2);
  __syncthreads();
}
DEVI void plain_tile256(const bf* A, int lda, const bf* Wt, int K, bf* C, int ldc, long row0, int n0, char* smem) {
  const int tid = get_tid(), lane = tid & 63, w = tid >> 6, wr = w >> 1, wc = w & 1, l15 = lane & 15, quad = lane >> 4;
  f32x4 acc[8][4];
#pragma unroll
  for (int m = 0; m < 8; ++m)
#pragma unroll
    for (int n = 0; n < 4; ++n) acc[m][n] = f32x4{0.f, 0.f, 0.f, 0.f};
  gemm_core3(acc, A + row0 * lda, lda, Wt + (long)n0 * K, K, K, smem);
  bf* tl = reinterpret_cast<bf*>(smem);
#pragma unroll
  for (int m = 0; m < 8; ++m)
#pragma unroll
    for (int n = 0; n < 4; ++n) {
      const int cl = wc * 64 + n * 16 + l15;
#pragma unroll
      for (int j = 0; j < 4; ++j) tl[(wr * 128 + m * 16 + quad * 4 + j) * 136 + cl] = f2bf(acc[m][n][j]);
    }
  __syncthreads();
  tile_store256<128>(smem, C, ldc, row0, n0);
  __syncthreads();
}

DEVI void phase_ffn1(const P& p, int f, char* smem) {
  const bf* W = p.W13 + (long)f * 5632 * 1024;
  for (int v = blockIdx.x; v < 128 * 44; v += gridDim.x) {
    int m2, nt;
    lat_tile_map256(v, 44, m2, nt);
    ffn1_tile256(p, W, lat_row0_256(m2), nt * 128, smem);
  }
  for (int u = blockIdx.x; u < 4 * 88; u += gridDim.x) ffn1_tile<2>(p, W, ctx_row0(u & 3), (u >> 2) * 64, smem);
}

template <int NTW>
DEVI void plain_tile(const bf* A, int lda, const bf* Wt, int K, bf* C, int ldc, long row0, int n0, char* smem) {
  const int tid = get_tid(), lane = tid & 63, w = tid >> 6, wr = w >> 1, wc = w & 1, l15 = lane & 15, quad = lane >> 4;
  constexpr int BN = 32 * NTW;
  constexpr int LDT = BN + 8;
  f32x4 acc[4][NTW];
  zero_acc<NTW>(acc);
  gemm_core2<NTW>(acc, A + row0 * lda, lda, Wt + (long)n0 * K, K, K, smem);
  bf* tl = reinterpret_cast<bf*>(smem);
#pragma unroll
  for (int m = 0; m < 4; ++m)
#pragma unroll
    for (int n = 0; n < NTW; ++n) {
      const int cl = wc * 16 * NTW + n * 16 + l15;
#pragma unroll
      for (int j = 0; j < 4; ++j) tl[(wr * 64 + m * 16 + quad * 4 + j) * LDT + cl] = f2bf(acc[m][n][j]);
    }
  __syncthreads();
  tile_store<BN>(smem, C, ldc, row0, n0);
  __syncthreads();
}

DEVI void phase_gemm_plain128(const bf* A, int lda, const bf* Wt, int K, int N, bf* C, int ldc, char* smem) {
  const int ntn = N / 128;
  for (int v = blockIdx.x; v < 128 * ntn; v += gridDim.x) {
    int m2, nt;
    lat_tile_map256(v, ntn, m2, nt);
    plain_tile256(A, lda, Wt, K, C, ldc, lat_row0_256(m2), nt * 128, smem);
  }
  const int nc = N / 32;
  for (int u = blockIdx.x; u < 4 * nc; u += gridDim.x) plain_tile<1>(A, lda, Wt, K, C, ldc, ctx_row0(u & 3), (u >> 2) * 32, smem);
}

DEVI void glu_tile(const P& p, long row0, int nt, char* smem) {
  const int tid = get_tid(), lane = tid & 63, w = tid >> 6, wr = w >> 1, wc = w & 1, l15 = lane & 15, quad = lane >> 4;
  f32x4 acc[4][2];
  zero_acc<2>(acc);
  gemm_core2<2>(acc, p.gbuf + row0 * 256, 256, p.WGLU + (long)nt * 64 * 256, 256, 256, smem);
  bf* tl = reinterpret_cast<bf*>(smem);
  {
    const int r = tid >> 1, half = tid & 1;
#pragma unroll
    for (int c = 0; c < 4; ++c)
      *reinterpret_cast<u32x4*>(tl + r * 72 + half * 32 + c * 8) =
          *reinterpret_cast<const u32x4*>(p.gbuf + (row0 + r) * 256 + nt * 64 + half * 32 + c * 8);
  }
  __syncthreads();
#pragma unroll
  for (int m = 0; m < 4; ++m)
#pragma unroll
    for (int n = 0; n < 2; ++n) {
      const int cl = wc * 32 + n * 16 + l15;
#pragma unroll
      for (int j = 0; j < 4; ++j) {
        const int rl = wr * 64 + m * 16 + quad * 4 + j;
        const float g = bf2f(tl[rl * 72 + cl]);
        tl[rl * 72 + cl] = f2bf(g * sigm(acc[m][n][j]));
      }
    }
  __syncthreads();
  tile_store<64>(smem, p.BR, DM, row0, nt * 64);
  __syncthreads();
}
DEVI void phase_glu(const P& p, char* smem) {
  for (int v = blockIdx.x; v < 256 * 4; v += gridDim.x) {
    int mtl, nt;
    lat_tile_map(v, 4, mtl, nt);
    glu_tile(p, lat_row0(mtl), nt, smem);
  }
  for (int u = blockIdx.x; u < 16; u += gridDim.x) glu_tile(p, ctx_row0(u & 3), u >> 2, smem);
}

template <int NTW>
DEVI void merge_tile(const P& p, long row0, int n0, char* smem) {
  const int tid = get_tid(), lane = tid & 63, w = tid >> 6, wr = w >> 1, wc = w & 1, l15 = lane & 15, quad = lane >> 4;
  constexpr int BN = 32 * NTW, LDT = BN + 8;
  f32x4 accM[4][NTW];
  zero_acc<NTW>(accM);
#pragma unroll 1
  for (int i = 0; i < 4; ++i) {
    unsigned pg[4][NTW][2];
    {
      f32x4 accT[4][NTW];
      zero_acc<NTW>(accT);
      gemm_core2<NTW, true>(accT, p.H + row0 * DM, DM, p.WIN + ((long)2400 + i * 1024 + n0) * 1024, 1024, 1024, smem);
#pragma unroll
      for (int m = 0; m < 4; ++m)
#pragma unroll
        for (int n = 0; n < NTW; ++n) {
          pg[m][n][0] = pack2(sigm(accT[m][n][0]), sigm(accT[m][n][1]));
          pg[m][n][1] = pack2(sigm(accT[m][n][2]), sigm(accT[m][n][3]));
        }
    }
    f32x4 accT[4][NTW];
    zero_acc<NTW>(accT);
    gemm_core2<NTW, true, true>(accT, p.BR + row0 * DM + i * 256, DM, p.WB + ((long)i * 1024 + n0) * 256, 256, 256, smem);
#pragma unroll
    for (int m = 0; m < 4; ++m)
#pragma unroll
      for (int n = 0; n < NTW; ++n) {
        accM[m][n][0] += __uint_as_float(pg[m][n][0] << 16) * accT[m][n][0];
        accM[m][n][1] += __uint_as_float(pg[m][n][0] & 0xffff0000u) * accT[m][n][1];
        accM[m][n][2] += __uint_as_float(pg[m][n][1] << 16) * accT[m][n][2];
        accM[m][n][3] += __uint_as_float(pg[m][n][1] & 0xffff0000u) * accT[m][n][3];
      }
  }
  bf* tl = reinterpret_cast<bf*>(smem);
#pragma unroll
  for (int m = 0; m < 4; ++m)
#pragma unroll
    for (int n = 0; n < NTW; ++n) {
      const int cl = wc * 16 * NTW + n * 16 + l15;
#pragma unroll
      for (int j = 0; j < 4; ++j) tl[(wr * 64 + m * 16 + quad * 4 + j) * LDT + cl] = f2bf(accM[m][n][j]);
    }
  __syncthreads();
  tile_store<BN>(smem, p.UZ, DM, row0, n0);
  __syncthreads();
}
DEVI void phase_merge(const P& p, char* smem) {
  for (int v = blockIdx.x; v < 256 * 8; v += gridDim.x) {
    int mtl, nt;
    lat_tile_map(v, 8, mtl, nt);
    merge_tile<4>(p, lat_row0(mtl), nt * 128, smem);
  }
  for (int u = blockIdx.x; u < 64; u += gridDim.x) merge_tile<2>(p, ctx_row0(u & 3), (u >> 2) * 64, smem);
}

DEVI void mla_q_tile(const P& p, int mt, int h, char* smem) {
  const int tid = get_tid(), lane = tid & 63, w = tid >> 6, wr = w >> 1, wc = w & 1, l15 = lane & 15, quad = lane >> 4;
  float* rowss = reinterpret_cast<float*>(smem + 2 * (128 * 144 + 128 * 144));
  rowss = reinterpret_cast<float*>(smem);
  f32x4 acc[4][4];
  zero_acc<4>(acc);
  gemm_core<4, true>(acc, p.UZ + (long)mt * 128 * ZLD + 256, ZLD, p.WUQ + (long)h * 128 * 192, 192, 192, smem, rowss);
  const float SC = 0.10206207261596575f * LOG2E;
  const int b = (mt * 128) / RB;
#pragma unroll
  for (int m = 0; m < 4; ++m) {
#pragma unroll
    for (int j = 0; j < 4; ++j) {
      const int rl = wr * 64 + m * 16 + quad * 4 + j;
      const int r = mt * 128 + rl;
      const int jj = r - b * RB;
      const float rs = rsqrtf(rowss[rl] * (1.f / 192.f) + EPS) * SC;
      bf* qrow = p.Qb + ((long)(b * 4 + h) * RB + jj) * 96;
      if (wc == 0) {
#pragma unroll
        for (int n = 0; n < 4; ++n) qrow[n * 16 + l15] = f2bf(acc[m][n][j] * rs);
      } else {
        const bool lat = jj >= CTXL;
        const int t = jj - CTXL;
        const float inv = ex2(-(float)(l15 & 7) * (L2_10000 / 8.f));
#pragma unroll
        for (int pr = 0; pr < 2; ++pr) {
          float xr = acc[m][2 * pr][j] * rs, xt = acc[m][2 * pr + 1][j] * rs;
          float o = xr;
          if (lat) {
            float pos = (pr == 0) ? (float)(t >> 6) : (float)(t & 63);
            float th = pos * inv;
            o = xr * __cosf(th) + xt * __sinf(th);
          }
          qrow[64 + pr * 16 + l15] = f2bf(o);
        }
      }
    }
  }
  __syncthreads();
}

DEVI void mla_kv_tile(const P& p, int mt, int h, char* smem) {
  const int tid = get_tid(), lane = tid & 63, w = tid >> 6, wr = w >> 1, wc = w & 1, l15 = lane & 15, quad = lane >> 4;
  float* rowss = reinterpret_cast<float*>(smem);
  f32x4 acc[4][4];
  zero_acc<4>(acc);
  gemm_core<4, true>(acc, p.UZ + (long)mt * 128 * ZLD + 448, ZLD, p.WUKV + (long)h * 128 * 128, 128, 128, smem, rowss);
  const int b = (mt * 128) / RB;
#pragma unroll
  for (int m = 0; m < 4; ++m) {
    const int rl0 = wr * 64 + m * 16 + quad * 4;
    const int jj0 = mt * 128 + rl0 - b * RB;
    float rs[4];
#pragma unroll
    for (int j = 0; j < 4; ++j) rs[j] = rsqrtf(rowss[rl0 + j] * (1.f / 128.f) + EPS);
    if (wc == 0) {
#pragma unroll
      for (int j = 0; j < 4; ++j) {
        bf* krow = p.Kb + ((long)(b * 4 + h) * RB + jj0 + j) * 96;
#pragma unroll
        for (int n = 0; n < 4; ++n) krow[n * 16 + l15] = f2bf(acc[m][n][j] * rs[j]);
      }
    } else {
#pragma unroll
      for (int n = 0; n < 4; ++n) {
        const int cdv = n * 16 + l15;
        u32x2 o;
        o[0] = pack2(acc[m][n][0] * rs[0], acc[m][n][1] * rs[1]);
        o[1] = pack2(acc[m][n][2] * rs[2], acc[m][n][3] * rs[3]);
        *reinterpret_cast<u32x2*>(p.Vtb + ((long)(b * 4 + h) * 64 + cdv) * RB + jj0) = o;
      }
    }
  }
  __syncthreads();
}

DEVI void rowprep_item(const P& p, int l, int it, char* smem) {
  const int tid = get_tid(), lane = tid & 63, w = tid >> 6;
  bf* vt = reinterpret_cast<bf*>(smem);
  const int r0 = it * 64;
  const int b = r0 / RB;
  const int j0 = r0 - b * RB;
  const float qn = p.qn_gqa[l * 64 + lane], kn = p.kn_gqa[l * 64 + lane];
  const float inv64 = ex2(-(float)(lane & 15) * (L2_10000 / 16.f));
  const float inv32 = ex2(-(float)(lane & 7) * (L2_10000 / 8.f));
  const float QS = 0.125f * LOG2E;
  for (int rr = 0; rr < 16; ++rr) {
    const int rl = w * 16 + rr;
    const int jj = j0 + rl;
    const bf* zr = p.UZ + (long)(r0 + rl) * ZLD;
    const bool lat = jj >= CTXL;
    const int t = jj - CTXL;
    const float prow = (float)(t >> 6), pcol = (float)(t & 63);
    float cs64 = 1.f, sn64 = 0.f, cs32 = 1.f, sn32 = 0.f;
    if (lat) {
      float th = ((lane >> 5) ? pcol : prow) * inv64;
      cs64 = __cosf(th); sn64 = __sinf(th);
      float th2 = (((lane >> 4) & 1) ? pcol : prow) * inv32;
      cs32 = __cosf(th2); sn32 = __sinf(th2);
    }
#pragma unroll
    for (int h = 0; h < 4; ++h) {
      float v = bf2f(zr[1888 + h * 64 + lane]);
      float ss = wave_sum(v * v);
      float y = v * rsqrtf(ss * (1.f / 64.f) + EPS) * qn;
      float pt = __shfl_xor(y, 16);
      float rot = (lane & 16) ? pt : -pt;
      float o = y * cs64 + rot * sn64;
      p.Qd[((long)(b * 4 + h) * RB + jj) * 64 + lane] = f2bf(o * QS);
    }
#pragma unroll
    for (int hk = 0; hk < 2; ++hk) {
      float v = bf2f(zr[2144 + hk * 64 + lane]);
      float ss = wave_sum(v * v);
      float y = v * rsqrtf(ss * (1.f / 64.f) + EPS) * kn;
      float pt = __shfl_xor(y, 16);
      float rot = (lane & 16) ? pt : -pt;
      float o = y * cs64 + rot * sn64;
      p.Kd[((long)(b * 2 + hk) * RB + jj) * 64 + lane] = f2bf(o);
    }
    {
      float v = bf2f(zr[576 + (lane & 31)]);
      float pt = __shfl_xor(v, 8);
      float rot = (lane & 8) ? pt : -pt;
      float o = v * cs32 + rot * sn32;
      if (lane < 32) {
        bf ob = f2bf(o);
#pragma unroll
        for (int h = 0; h < 4; ++h) p.Kb[((long)(b * 4 + h) * RB + jj) * 96 + 64 + lane] = ob;
      }
    }
    {
      unsigned u = *reinterpret_cast<const unsigned*>(zr + 2272 + lane * 2);
      vt[rl * 130 + lane * 2] = (bf)(u & 0xffffu);
      vt[rl * 130 + lane * 2 + 1] = (bf)(u >> 16);
    }
  }
  __syncthreads();
  {
    const int cidx = tid >> 1, half = tid & 1;
    bf* dst = p.VdT + ((long)(b * 2 + (cidx >> 6)) * 64 + (cidx & 63)) * RB + j0 + half * 32;
#pragma unroll
    for (int q = 0; q < 4; ++q) {
      u32x4 o;
#pragma unroll
      for (int e = 0; e < 4; ++e) {
        int ra = half * 32 + q * 8 + e * 2;
        o[e] = (unsigned)vt[ra * 130 + cidx] | ((unsigned)vt[(ra + 1) * 130 + cidx] << 16);
      }
      *reinterpret_cast<u32x4*>(dst + q * 8) = o;
    }
  }
  __syncthreads();
}

DEVI int s5_rc(int d, int ci) { return d == 0 ? ci : (ci < 2 ? 1 - ci : 131 - ci); }

DEVI void s5_bfrags(const P& p, int ldg, int l15, int quad, bf16x8 (&bfu)[8]) {
#pragma unroll
  for (int nt = 0; nt < 8; ++nt) {
    const int pp = (nt * 16 + l15) >> 1;
    const float* src = (l15 & 1) ? p.s5Bim : p.s5Bre;
    u32x4 wv = {0u, 0u, 0u, 0u};
    if (quad < 2) {
#pragma unroll
      for (int e = 0; e < 4; ++e) {
        const int n = quad * 8 + 2 * e;
        wv[e] = pack2(src[((long)ldg * 16 + n) * 64 + pp], src[((long)ldg * 16 + n + 1) * 64 + pp]);
      }
    }
    bfu[nt] = as_bf8(wv);
  }
}
DEVI void s5_bu_tile(const P& p, const bf16x8 (&bfu)[8], long trow0, int g, bf* XB, int l15, int quad) {
#pragma unroll
  for (int tt = 0; tt < 2; ++tt) {
    u32x4 ua = {0u, 0u, 0u, 0u};
    if (quad < 2) ua = *reinterpret_cast<const u32x4*>(p.UZ + (trow0 + tt * 16 + l15) * ZLD + g * 16 + quad * 8);
    const bf16x8 af = as_bf8(ua);
    f32x4 c[8];
#pragma unroll
    for (int nt = 0; nt < 8; ++nt) {
      c[nt] = f32x4{0.f, 0.f, 0.f, 0.f};
      c[nt] = mfma16(af, bfu[nt], c[nt]);
    }
    __builtin_amdgcn_sched_barrier(0);
    asm volatile("s_nop 7");
    asm volatile("s_nop 7");
    __builtin_amdgcn_sched_barrier(0);
#pragma unroll
    for (int nt = 0; nt < 8; ++nt)
#pragma unroll
      for (int j = 0; j < 4; ++j) XB[(tt * 16 + quad * 4 + j) * 144 + nt * 16 + l15] = f2bf(c[nt][j]);
  }
}

DEVI void s5_local_item(const P& p, int l, int it, char* smem) {
  const int tid = get_tid(), lane = tid & 63, w = tid >> 6, l15 = lane & 15, quad = lane >> 4;
  const int gq = it & 3; int t1 = it >> 2; const int ci = t1 % 130; t1 /= 130; const int d = t1 & 1, b = t1 >> 1;
  const int g = gq * 4 + w;
  const int rc = s5_rc(d, ci);
  const long row0 = (long)b * RB + rc * 128;
  bf* XB = reinterpret_cast<bf*>(smem + w * 9216);
  const int ldg = (l * 2 + d) * 16 + g;
  const float are = p.s5A[(ldg * 64 + lane) * 2], aim = p.s5A[(ldg * 64 + lane) * 2 + 1];
  bf16x8 bfu[8];
  s5_bfrags(p, ldg, l15, quad, bfu);
  float xr = 0.f, xi = 0.f;
#pragma unroll 1
  for (int sc = 0; sc < 4; ++sc) {
    const int sub = d ? 3 - sc : sc;
    s5_bu_tile(p, bfu, row0 + sub * 32, g, XB, l15, quad);
    __syncthreads();
#pragma unroll 4
    for (int s = 0; s < 32; ++s) {
      const int t = d ? 31 - s : s;
      const unsigned w2 = *reinterpret_cast<const unsigned*>(XB + t * 144 + 2 * lane);
      const float br = __uint_as_float(w2 << 16), bi = __uint_as_float(w2 & 0xffff0000u);
      const float nr = are * xr - aim * xi + br;
      const float ni = are * xi + aim * xr + bi;
      xr = nr; xi = ni;
    }
    __syncthreads();
  }
  float* e = p.s5E + ((((long)(b * 2 + d) * 130 + ci) * 16 + g) * 64 + lane) * 2;
  e[0] = xr; e[1] = xi;
}

DEVI void s5_scan_item(const P& p, int l, int it) {
  const int idx = it * 256 + get_tid();
  const int pp = idx & 63, g = (idx >> 6) & 15, d = (idx >> 10) & 1, b = idx >> 11;
  const int ldg = (l * 2 + d) * 16 + g;
  float ar = p.s5A[(ldg * 64 + pp) * 2], ai = p.s5A[(ldg * 64 + pp) * 2 + 1];
#pragma unroll
  for (int q = 0; q < 7; ++q) { float nr = ar * ar - ai * ai, ni = 2.f * ar * ai; ar = nr; ai = ni; }
  float sr = 0.f, si = 0.f;
  const long base = ((long)(b * 2 + d) * 130) * 16 * 64 + g * 64 + pp;
#pragma unroll 13
  for (int ci = 0; ci < 130; ++ci) {
    const long o = (base + (long)ci * 1024) * 2;
    float er = p.s5E[o], ei = p.s5E[o + 1];
    p.s5Cin[o] = sr; p.s5Cin[o + 1] = si;
    float nr = ar * sr - ai * si + er, ni = ar * si + ai * sr + ei;
    sr = nr; si = ni;
  }
}

template <int DIR>
DEVI void s5_out_dir(const P& p, int l, int b, int rc, int g, long row0, bf* XB, f32x4 (&yacc)[8]) {
  const int lane = get_tid() & 63, l15 = lane & 15, quad = lane >> 4;
  const int ldg = (l * 2 + DIR) * 16 + g;
  const float are = p.s5A[(ldg * 64 + lane) * 2], aim = p.s5A[(ldg * 64 + lane) * 2 + 1];
  bf16x8 bfu[8];
  s5_bfrags(p, ldg, l15, quad, bfu);
  bf16x8 cf[4];
#pragma unroll
  for (int ks = 0; ks < 4; ++ks) {
    u32x4 wv;
#pragma unroll
    for (int e = 0; e < 4; ++e) {
      const int pp = ks * 16 + quad * 4 + e;
      float cr = p.c_re[((long)ldg * 16 + l15) * 64 + pp];
      float ci = p.c_im[((long)ldg * 16 + l15) * 64 + pp];
      wv[e] = pack2(cr, -ci);
    }
    cf[ks] = as_bf8(wv);
  }
  const int ci = s5_rc(DIR, rc);
  const float* cin = p.s5Cin + ((((long)(b * 2 + DIR) * 130 + ci) * 16 + g) * 64 + lane) * 2;
  float xr = cin[0], xi = cin[1];
#pragma unroll
  for (int sc = 0; sc < 4; ++sc) {
    const int sub = DIR ? 3 - sc : sc;
    s5_bu_tile(p, bfu, row0 + sub * 32, g, XB, l15, quad);
    __syncthreads();
#pragma unroll 4
    for (int s = 0; s < 32; ++s) {
      const int t = DIR ? 31 - s : s;
      unsigned* xp = reinterpret_cast<unsigned*>(XB + t * 144 + 2 * lane);
      const unsigned w2 = *xp;
      const float br = __uint_as_float(w2 << 16), bi = __uint_as_float(w2 & 0xffff0000u);
      const float nr = are * xr - aim * xi + br;
      const float ni = are * xi + aim * xr + bi;
      xr = nr; xi = ni;
      *xp = pack2(xr, xi);
    }
    __syncthreads();
#pragma unroll
    for (int tt = 0; tt < 2; ++tt)
#pragma unroll
      for (int ks = 0; ks < 4; ++ks) {
        bf16x8 a = *reinterpret_cast<const bf16x8*>(XB + (tt * 16 + l15) * 144 + ks * 32 + quad * 8);
        yacc[sub * 2 + tt] = mfma16(a, cf[ks], yacc[sub * 2 + tt]);
      }
    __syncthreads();
  }
}

DEVI void s5_out_item(const P& p, int l, int it, char* smem) {
  const int tid = get_tid(), lane = tid & 63, w = tid >> 6, l15 = lane & 15, quad = lane >> 4;
  const int gq = it & 3; int t1 = it >> 2; const int rc = t1 % 130; const int b = t1 / 130;
  const int g = gq * 4 + w;
  const long row0 = (long)b * RB + rc * 128;
  bf* XB = reinterpret_cast<bf*>(smem + w * 9216);
  f32x4 yacc[8];
#pragma unroll
  for (int i = 0; i < 8; ++i) yacc[i] = f32x4{0.f, 0.f, 0.f, 0.f};
  s5_out_dir<0>(p, l, b, rc, g, row0, XB, yacc);
  s5_out_dir<1>(p, l, b, rc, g, row0, XB, yacc);
  const float dsk = p.s5d[l * 256 + g * 16 + l15];
#pragma unroll
  for (int tt = 0; tt < 8; ++tt)
#pragma unroll
    for (int j = 0; j < 4; ++j) {
      const long row = row0 + tt * 16 + quad * 4 + j;
      float u = bf2f(p.UZ[row * ZLD + g * 16 + l15]);
      float y = yacc[tt][j] + dsk * u;
      p.gbuf[row * 256 + g * 16 + l15] = f2bf(gelu_tanh(y));
    }
}


DEVI void ld16(const bf* p, float (&o)[16]) {
  u32x4 a = *reinterpret_cast<const u32x4*>(p), b = *reinterpret_cast<const u32x4*>(p + 8);
#pragma unroll
  for (int e = 0; e < 4; ++e) {
    o[2 * e] = __uint_as_float(a[e] << 16); o[2 * e + 1] = __uint_as_float(a[e] & 0xffff0000u);
    o[8 + 2 * e] = __uint_as_float(b[e] << 16); o[8 + 2 * e + 1] = __uint_as_float(b[e] & 0xffff0000u);
  }
}
DEVI int hg_rc(int d, int ci) { return d == 0 ? ci : (ci < 4 ? 3 - ci : 263 - ci); }
DEVI float hg_lb(const P& p, int l, int d, int ch) {
  if (l == 0) return 0.f;
  float r0 = p.lb_raw[(d * 2 + 0) * 256 + ch], r1 = p.lb_raw[(d * 2 + 1) * 256 + ch];
  return fminf(fmaxf(sigm(r1 - r0), 0.f), 1.f);
}

DEVI void hgrn_cumsum(float* arr, float* segt, int d, int tid) {
  const int k = tid & 63, seg = tid >> 6;
  float v[16];
  float c = 0.f;
#pragma unroll
  for (int s = 0; s < 16; ++s) { const int q = seg * 16 + s; const int t = d ? 63 - q : q; c += arr[t * 68 + k]; v[s] = c; }
  segt[seg * 64 + k] = c;
  __syncthreads();
  float off = 0.f;
#pragma unroll
  for (int s2 = 0; s2 < 3; ++s2) if (s2 < seg) off += segt[s2 * 64 + k];
#pragma unroll
  for (int s = 0; s < 16; ++s) { const int q = seg * 16 + s; const int t = d ? 63 - q : q; arr[t * 68 + k] = v[s] + off; }
  __syncthreads();
}

DEVI void hgrn_local_item(const P& p, int l, int it, char* smem) {
  const int tid = get_tid(), lane = tid & 63, w = tid >> 6, l15 = lane & 15, quad = lane >> 4;
  const int rc = it % 260; int t1 = it / 260; const int h = t1 & 3, d = (t1 >> 2) & 1, b = t1 >> 3;
  const long row0 = (long)b * RB + rc * 64;
  float* lf = reinterpret_cast<float*>(smem);
  bf* KKt = reinterpret_cast<bf*>(smem + 17408);
  bf* Vt = reinterpret_cast<bf*>(smem + 17408 + 9216);
  float* tot = reinterpret_cast<float*>(smem + 17408 + 2 * 9216);
  const int t = tid >> 2, k0 = (tid & 3) * 16;
  const bf* zr = p.UZ + (row0 + t) * ZLD;
  float kv[16];
  {
    float zfv[16], vv[16];
    ld16(zr + 1120 + d * 256 + h * 64 + k0, zfv);
    ld16(zr + 864 + h * 64 + k0, vv);
#pragma unroll
    for (int e = 0; e < 16; ++e) {
      const int k = k0 + e;
      float zf = zfv[e];
      float lb = hg_lb(p, l, d, h * 64 + k);
      float sg = sigm(zf);
      float f = lb + (1.f - lb) * sg;
      lf[t * 68 + k] = __log2f(fmaxf(f, 1e-20f));
      kv[e] = (1.f - lb) * sigm(-zf);
      Vt[k * 72 + t] = f2bf(vv[e]);
    }
  }
  __syncthreads();
  hgrn_cumsum(lf, reinterpret_cast<float*>(smem + 36864), d, tid);
  const int tlast = d ? 0 : 63;
#pragma unroll
  for (int e = 0; e < 16; ++e) { const int k = k0 + e; KKt[k * 72 + t] = f2bf(kv[e] * ex2(lf[tlast * 68 + k] - lf[t * 68 + k])); }
  const long sbase = (((long)(b * 2 + d) * 4 + h) * 260 + rc);
  if (tid < 64) p.hD[sbase * 64 + tid] = ex2(lf[tlast * 68 + tid]);
  __syncthreads();
#pragma unroll
  for (int kt = 0; kt < 4; ++kt) {
    f32x4 acc = {0.f, 0.f, 0.f, 0.f};
#pragma unroll
    for (int ks = 0; ks < 2; ++ks) {
      bf16x8 a = *reinterpret_cast<const bf16x8*>(Vt + (w * 16 + l15) * 72 + ks * 32 + quad * 8);
      bf16x8 bb = *reinterpret_cast<const bf16x8*>(KKt + (kt * 16 + l15) * 72 + ks * 32 + quad * 8);
      acc = mfma16(a, bb, acc);
    }
#pragma unroll
    for (int j = 0; j < 4; ++j) p.hS[(sbase * 64 + w * 16 + quad * 4 + j) * 64 + kt * 16 + l15] = f2bf(acc[j]);
  }
  __syncthreads();
}

DEVI void hgrn_scan_item(const P& p, int it) {
  const int seq = it >> 4;
  const int d = (seq >> 2) & 1;
  const int el = (it & 15) * 256 + get_tid();
  const int k = el & 63;
  float s = 0.f;
  const long sb = (long)seq * 260;
#pragma unroll 20
  for (int ci = 0; ci < 260; ++ci) {
    const int rc = hg_rc(d, ci);
    const long o = (sb + rc) * 4096 + el;
    float loc = bf2f(p.hS[o]);
    float dk = p.hD[(sb + rc) * 64 + k];
    p.hS[o] = f2bf(s);
    s = dk * s + loc;
  }
}

DEVI void hgrn_out_item(const P& p, int l, int it, char* smem) {
  const int tid = get_tid(), lane = tid & 63, w = tid >> 6, l15 = lane & 15, quad = lane >> 4;
  const int rc = it % 260; const int t1 = it / 260; const int h = t1 & 3, b = t1 >> 2;
  const long row0 = (long)b * RB + rc * 64;
  float* cum = reinterpret_cast<float*>(smem);
  bf* qb = reinterpret_cast<bf*>(smem + 17408);
  bf* kvb = reinterpret_cast<bf*>(smem + 26624);
  bf* Stb = reinterpret_cast<bf*>(smem + 35840);
  bf* Vtb = reinterpret_cast<bf*>(smem + 45056);
  bf* attb = reinterpret_cast<bf*>(smem + 54272);
  f32x4 oacc[4];
#pragma unroll
  for (int i = 0; i < 4; ++i) oacc[i] = f32x4{0.f, 0.f, 0.f, 0.f};
  const int t = tid >> 2, k0 = (tid & 3) * 16;
  const bf* zr = p.UZ + (row0 + t) * ZLD;
#pragma unroll 1
  for (int d = 0; d < 2; ++d) {
    {
      float zfv[16], vv[16];
      ld16(zr + 1120 + d * 256 + h * 64 + k0, zfv);
      ld16(zr + 864 + h * 64 + k0, vv);
      const u32x4 q0 = *reinterpret_cast<const u32x4*>(zr + 608 + h * 64 + k0), q1 = *reinterpret_cast<const u32x4*>(zr + 608 + h * 64 + k0 + 8);
      *reinterpret_cast<u32x4*>(qb + t * 72 + k0) = q0;
      *reinterpret_cast<u32x4*>(qb + t * 72 + k0 + 8) = q1;
#pragma unroll
      for (int e = 0; e < 16; ++e) {
        const int k = k0 + e;
        float zf = zfv[e];
        float lb = hg_lb(p, l, d, h * 64 + k);
        float f = lb + (1.f - lb) * sigm(zf);
        cum[t * 68 + k] = __log2f(fmaxf(f, 1e-20f));
        kvb[t * 72 + k] = f2bf((1.f - lb) * sigm(-zf));
        Vtb[k * 72 + t] = f2bf(vv[e]);
      }
    }
    {
      const long sbase = (((long)(b * 2 + d) * 4 + h) * 260 + rc) * 4096;
      const bf* sp = p.hS + sbase + t * 64 + k0;
      u32x4 s0 = *reinterpret_cast<const u32x4*>(sp), s1 = *reinterpret_cast<const u32x4*>(sp + 8);
      *reinterpret_cast<u32x4*>(Stb + t * 72 + k0) = s0;
      *reinterpret_cast<u32x4*>(Stb + t * 72 + k0 + 8) = s1;
    }
    __syncthreads();
    hgrn_cumsum(cum, reinterpret_cast<float*>(smem + 72704), d, tid);
    {
      {
        const int jq = t >> 4;
#pragma unroll
        for (int e = 0; e < 16; ++e) {
          const int k = k0 + e;
          float r;
          if (d == 0) r = (jq > 0) ? cum[(16 * jq - 1) * 68 + k] : 0.f;
          else r = (jq < 3) ? cum[(16 * jq + 16) * 68 + k] : 0.f;
          kvb[t * 72 + k] = f2bf(bf2f(kvb[t * 72 + k]) * ex2(fminf(r - cum[t * 68 + k], 100.f)));
        }
      }
      __syncthreads();
      bf* qs = reinterpret_cast<bf*>(smem + 63488) + w * 1152;
      const int tq = 16 * w + (lane >> 2), kq0 = (lane & 3) * 16;
#pragma unroll 1
      for (int jg = 0; jg < 4; ++jg) {
        const bool gv = d == 0 ? (jg <= w) : (jg >= w);
        if (gv) {
#pragma unroll
          for (int e = 0; e < 16; ++e) {
            const int k = kq0 + e;
            float r;
            if (d == 0) r = (jg > 0) ? cum[(16 * jg - 1) * 68 + k] : 0.f;
            else r = (jg < 3) ? cum[(16 * jg + 16) * 68 + k] : 0.f;
            qs[(lane >> 2) * 72 + k] = f2bf(bf2f(qb[tq * 72 + k]) * ex2(cum[tq * 68 + k] - r));
          }
        }
        __syncthreads();
        if (gv) {
          f32x4 ac = {0.f, 0.f, 0.f, 0.f};
#pragma unroll
          for (int ks = 0; ks < 2; ++ks) {
            bf16x8 a1 = *reinterpret_cast<const bf16x8*>(qs + l15 * 72 + ks * 32 + quad * 8);
            bf16x8 b1 = *reinterpret_cast<const bf16x8*>(kvb + (16 * jg + l15) * 72 + ks * 32 + quad * 8);
            ac = mfma16(a1, b1, ac);
          }
#pragma unroll
          for (int j = 0; j < 4; ++j) {
            const int ta = 16 * w + quad * 4 + j, sg = 16 * jg + l15;
            const bool ok = d == 0 ? (sg <= ta) : (sg >= ta);
            attb[ta * 72 + sg] = f2bf(ok ? ac[j] : 0.f);
          }
        } else {
#pragma unroll
          for (int j = 0; j < 4; ++j) attb[(16 * w + quad * 4 + j) * 72 + 16 * jg + l15] = 0;
        }
        __syncthreads();
      }
    }
#pragma unroll
    for (int e = 0; e < 16; ++e) { const int k = k0 + e; kvb[t * 72 + k] = f2bf(bf2f(qb[t * 72 + k]) * ex2(cum[t * 68 + k])); }
    __syncthreads();
#pragma unroll
    for (int vt = 0; vt < 4; ++vt)
#pragma unroll
      for (int ks = 0; ks < 2; ++ks) {
        bf16x8 a1 = *reinterpret_cast<const bf16x8*>(kvb + (w * 16 + l15) * 72 + ks * 32 + quad * 8);
        bf16x8 b1 = *reinterpret_cast<const bf16x8*>(Stb + (vt * 16 + l15) * 72 + ks * 32 + quad * 8);
        oacc[vt] = mfma16(a1, b1, oacc[vt]);
        bf16x8 a2 = *reinterpret_cast<const bf16x8*>(attb + (w * 16 + l15) * 72 + ks * 32 + quad * 8);
        bf16x8 b2 = *reinterpret_cast<const bf16x8*>(Vtb + (vt * 16 + l15) * 72 + ks * 32 + quad * 8);
        oacc[vt] = mfma16(a2, b2, oacc[vt]);
      }
    __syncthreads();
  }
#pragma unroll
  for (int j = 0; j < 4; ++j) {
    float ss = 0.f;
#pragma unroll
    for (int vt = 0; vt < 4; ++vt) ss += oacc[vt][j] * oacc[vt][j];
    ss += __shfl_xor(ss, 1); ss += __shfl_xor(ss, 2); ss += __shfl_xor(ss, 4); ss += __shfl_xor(ss, 8);
    const float rs = rsqrtf(ss * (1.f / 64.f) + EPS);
    const long row = row0 + w * 16 + quad * 4 + j;
#pragma unroll
    for (int vt = 0; vt < 4; ++vt) {
      const int c = vt * 16 + l15;
      float gt = bf2f(p.UZ[row * ZLD + 1632 + h * 64 + c]);
      float o = oacc[vt][j] * rs * p.onorm[l * 64 + c] * silu_(gt);
      p.BR[row * DM + 512 + h * 64 + c] = f2bf(o);
    }
  }
}

template <int DK>
DEVI void attn_tile(const char* kb, const char* vb, const bool first, const bf16x8 (&qf)[2][DK / 32], f32x4 (&o)[2][4],
                    float (&mrun)[2], float (&lsum)[2], const int l15, const int quad) {
  constexpr int KSTR = (DK == 64) ? 160 : 224;
  constexpr int NKK = DK / 32;
  f32x4 s[2][4];
#pragma unroll
  for (int qt = 0; qt < 2; ++qt)
#pragma unroll
    for (int ks = 0; ks < 4; ++ks) { const float nm = -mrun[qt]; s[qt][ks] = f32x4{nm, nm, nm, nm}; }
#pragma unroll
  for (int ks = 0; ks < 4; ++ks)
#pragma unroll
    for (int kk = 0; kk < NKK; ++kk) {
      bf16x8 kf = *reinterpret_cast<const bf16x8*>(kb + (ks * 16 + l15) * KSTR + (kk * 32 + quad * 8) * 2);
      s[0][ks] = mfma16(kf, qf[0][kk], s[0][ks]);
      s[1][ks] = mfma16(kf, qf[1][kk], s[1][ks]);
    }
  bf16x8 pf[2][2];
#pragma unroll
  for (int qt = 0; qt < 2; ++qt) {
    float mx = fmaxf(fmaxf(s[qt][0][0], s[qt][0][1]), fmaxf(s[qt][0][2], s[qt][0][3]));
#pragma unroll
    for (int ks = 1; ks < 4; ++ks) mx = fmaxf(mx, fmaxf(fmaxf(s[qt][ks][0], s[qt][ks][1]), fmaxf(s[qt][ks][2], s[qt][ks][3])));
    if (__any(first || (mx > 8.f))) {
      float rm = fmaxf(mx, __shfl_xor(mx, 16));
      rm = fmaxf(rm, __shfl_xor(rm, 32));
      const float delta = first ? rm : fmaxf(rm, 0.f);
      const float alpha = first ? 1.f : ex2(-delta);
      mrun[qt] += delta;
      lsum[qt] *= alpha;
#pragma unroll
      for (int ks = 0; ks < 4; ++ks)
#pragma unroll
        for (int j = 0; j < 4; ++j) s[qt][ks][j] -= delta;
#pragma unroll
      for (int dd = 0; dd < 4; ++dd)
#pragma unroll
        for (int j = 0; j < 4; ++j) o[qt][dd][j] *= alpha;
    }
    float ps = 0.f;
#pragma unroll
    for (int ks = 0; ks < 4; ++ks)
#pragma unroll
      for (int j = 0; j < 4; ++j) { float pv = ex2(s[qt][ks][j]); s[qt][ks][j] = pv; ps += pv; }
    lsum[qt] += ps;
#pragma unroll
    for (int k2 = 0; k2 < 2; ++k2) {
      u32x4 wv;
      wv[0] = pack2(s[qt][2 * k2][0], s[qt][2 * k2][1]);
      wv[1] = pack2(s[qt][2 * k2][2], s[qt][2 * k2][3]);
      wv[2] = pack2(s[qt][2 * k2 + 1][0], s[qt][2 * k2 + 1][1]);
      wv[3] = pack2(s[qt][2 * k2 + 1][2], s[qt][2 * k2 + 1][3]);
      pf[qt][k2] = as_bf8(wv);
    }
  }
#pragma unroll
  for (int dd = 0; dd < 4; ++dd)
#pragma unroll
    for (int k2 = 0; k2 < 2; ++k2) {
      u32x2 lo = *reinterpret_cast<const u32x2*>(vb + (dd * 16 + l15) * 144 + (k2 * 32 + quad * 4) * 2);
      u32x2 hi = *reinterpret_cast<const u32x2*>(vb + (dd * 16 + l15) * 144 + (k2 * 32 + 16 + quad * 4) * 2);
      u32x4 vv = {lo[0], lo[1], hi[0], hi[1]};
      bf16x8 vf = as_bf8(vv);
      o[0][dd] = mfma16(vf, pf[0][k2], o[0][dd]);
      o[1][dd] = mfma16(vf, pf[1][k2], o[1][dd]);
    }
}

template <int DK, int QP>
DEVI void attn_item(const bf* __restrict__ Q, const bf* __restrict__ Kp, const bf* __restrict__ Vt, bf* __restrict__ outp  ,
                    long row_base, int j0, int nkeys, char* smem) {
  constexpr int KSTR = (DK == 64) ? 160 : 224;
  constexpr int KSZ = 64 * KSTR, VSZ = 64 * 144, STG = KSZ + VSZ;
  constexpr int KCH = DK / 8;
  constexpr int NKL = (64 * KCH) / 256;
  constexpr int NKK = DK / 32;
  const int tid = get_tid(), lane = tid & 63, w = tid >> 6, l15 = lane & 15, quad = lane >> 4;
  bf16x8 qf[QP][2][NKK];
#pragma unroll
  for (int pr = 0; pr < QP; ++pr)
#pragma unroll
    for (int qt = 0; qt < 2; ++qt)
#pragma unroll
      for (int kk = 0; kk < NKK; ++kk)
        qf[pr][qt][kk] = *reinterpret_cast<const bf16x8*>(Q + (long)(j0 + w * (32 * QP) + pr * 32 + qt * 16 + l15) * DK + kk * 32 + quad * 8);
  f32x4 o[QP][2][4];
  float mrun[QP][2], lsum[QP][2];
#pragma unroll
  for (int pr = 0; pr < QP; ++pr)
#pragma unroll
    for (int qt = 0; qt < 2; ++qt) {
      mrun[pr][qt] = 0.f; lsum[pr][qt] = 0.f;
#pragma unroll
      for (int dd = 0; dd < 4; ++dd) o[pr][qt][dd] = f32x4{0.f, 0.f, 0.f, 0.f};
    }
  u32x4 rkA[NKL], rvA[2];
  const int nt = nkeys >> 6;
  int kr[NKL], kc[NKL];
#pragma unroll
  for (int i = 0; i < NKL; ++i) { const int c = tid + 256 * i; kr[i] = c / KCH; kc[i] = c - kr[i] * KCH; }
  const int vr = tid >> 3, vc = tid & 7;
#define ALOAD(RK, RV, T)                                                                                        \
  {                                                                                                             \
    _Pragma("unroll") for (int i = 0; i < NKL; ++i)                                                             \
      RK[i] = *reinterpret_cast<const u32x4*>(Kp + (long)((T)*64 + kr[i]) * DK + kc[i] * 8);                    \
    _Pragma("unroll") for (int i = 0; i < 2; ++i)                                                               \
      RV[i] = *reinterpret_cast<const u32x4*>(Vt + (long)(vr + 32 * i) * RB + (T)*64 + vc * 8);                 \
  }
#define AWRITE(RK, RV, S)                                                                                       \
  {                                                                                                             \
    _Pragma("unroll") for (int i = 0; i < NKL; ++i)                                                             \
      *reinterpret_cast<u32x4*>(smem + (S)*STG + kr[i] * KSTR + kc[i] * 16) = RK[i];                            \
    _Pragma("unroll") for (int i = 0; i < 2; ++i)                                                               \
      *reinterpret_cast<u32x4*>(smem + (S)*STG + KSZ + (vr + 32 * i) * 144 + vc * 16) = RV[i];                  \
  }
  ALOAD(rkA, rvA, 0);
  AWRITE(rkA, rvA, 0);
  __syncthreads();
  for (int t = 0; t < nt; ++t) {
    ALOAD(rkA, rvA, min(t + 1, nt - 1));
    const char* kb = smem + (t & 1) * STG;
#pragma unroll
    for (int pr = 0; pr < QP; ++pr) {
      attn_tile<DK>(kb, kb + KSZ, t == 0, qf[pr], o[pr], mrun[pr], lsum[pr], l15, quad);
      if (QP > 1) __builtin_amdgcn_sched_barrier(0);
    }
    AWRITE(rkA, rvA, (t + 1) & 1);
    __syncthreads();
  }
#undef ALOAD
#undef AWRITE
#pragma unroll
  for (int pr = 0; pr < QP; ++pr)
#pragma unroll
    for (int qt = 0; qt < 2; ++qt) {
      float ls = lsum[pr][qt];
      ls += __shfl_xor(ls, 16);
      ls += __shfl_xor(ls, 32);
      const float inv = 1.f / ls;
      const long row = row_base + j0 + w * (32 * QP) + pr * 32 + qt * 16 + l15;
#pragma unroll
      for (int dd = 0; dd < 4; ++dd) {
        u32x2 ov;
        ov[0] = pack2(o[pr][qt][dd][0] * inv, o[pr][qt][dd][1] * inv);
        ov[1] = pack2(o[pr][qt][dd][2] * inv, o[pr][qt][dd][3] * inv);
        *reinterpret_cast<u32x2*>(outp + row * DM + dd * 16 + quad * 4) = ov;
      }
    }
}

DEVI void attn_dispatch(const P& p, int it, char* smem) {
  if (it < 1024 || (it >= 1536 && it < 1552)) {
    int b, h, j0, nkeys;
    if (it < 1024) { b = it >> 9; h = (it >> 7) & 3; j0 = CTXL + (it & 127) * 128; nkeys = RB; }
    else { const int c = it - 1536; b = c >> 3; h = (c >> 1) & 3; j0 = (c & 1) * 128; nkeys = CTXL; }
    attn_item<96, 1>(p.Qb + (long)(b * 4 + h) * RB * 96, p.Kb + (long)(b * 4 + h) * RB * 96, p.Vtb + (long)(b * 4 + h) * 64 * RB,
                     p.BR + 256 + h * 64, (long)b * RB, j0, nkeys, smem);
  } else {
    int b, h, j0, nkeys;
    if (it < 1536) { const int r = it - 1024; b = r >> 8; h = (r >> 6) & 3; j0 = CTXL + (r & 63) * 256; nkeys = RB; }
    else { const int c = it - 1552; b = c >> 2; h = c & 3; j0 = 0; nkeys = CTXL; }
    const int hk = h >> 1;
    attn_item<64, 2>(p.Qd + (long)(b * 4 + h) * RB * 64, p.Kd + (long)(b * 2 + hk) * RB * 64, p.VdT + (long)(b * 2 + hk) * 64 * RB,
                     p.BR + 768 + h * 64, (long)b * RB, j0, nkeys, smem);
  }
}


#include <vector>

#define XB_TMO      128
#define XB_XCNT(j)  (256  + 64 * (j))
#define XB_XSUB(j)  (1280 + 64 * (j))
#define XB_XGEN(j)  (2304 + 64 * (j))
#define XB_TOP      3328
#define XB_TOPGEN   3392
#define XCD_BAR_WORDS 3456
#define XB_SPIN_CAP (1u << 18)
#define LAS __attribute__((address_space(3)))

__device__ __forceinline__ unsigned xb_ld(unsigned* p)              { return __hip_atomic_load(p, __ATOMIC_RELAXED, __HIP_MEMORY_SCOPE_AGENT); }
__device__ __forceinline__ unsigned xb_add(unsigned* p, unsigned v) { return __hip_atomic_fetch_add(p, v, __ATOMIC_RELAXED, __HIP_MEMORY_SCOPE_AGENT); }
__device__ __forceinline__ unsigned xb_xcc_id() { return (unsigned)__builtin_amdgcn_s_getreg((3 << 11) | 20) & 0xFu; }
#define XB_SPIN(cond, bar) do { unsigned _sp = 0; while (cond) { __builtin_amdgcn_s_sleep(1); \
    if ((++_sp & 255u) == 0u) { if (xb_ld(&(bar)[XB_TMO])) break; if (_sp > XB_SPIN_CAP) { atomicAdd(&(bar)[XB_TMO], 1u); break; } } } } while (0)

struct XcdBarrier {
    unsigned* bar; unsigned x;
    volatile LAS unsigned* st;
};

__device__ __forceinline__ XcdBarrier xcd_barrier_post(unsigned* bar, volatile LAS unsigned* st) {
    XcdBarrier b; b.bar = bar; b.x = xb_xcc_id(); b.st = st;
    if (threadIdx.x == 0) (void)xb_add(&bar[XB_XCNT(b.x)], 1u);
    return b;
}
__device__ __forceinline__ void xcd_barrier_complete(unsigned* bar, unsigned x, unsigned& nloc, unsigned& nx) {
    const unsigned G = gridDim.x * gridDim.y * gridDim.z;
    unsigned sum, cnt, mine, sp = 0u;
    for (;;) {
        sum = 0u; cnt = 0u; mine = 0u;
#pragma unroll
        for (unsigned j = 0; j < 16; ++j) { const unsigned c = xb_ld(&bar[XB_XCNT(j)]); sum += c; cnt += (c > 0u) ? 1u : 0u; mine = (j == x) ? c : mine; }
        if (sum == G) break;
        __builtin_amdgcn_s_sleep(1);
        if ((++sp & 255u) == 0u) { if (xb_ld(&bar[XB_TMO])) break; if (sp > XB_SPIN_CAP) { atomicAdd(&bar[XB_TMO], 1u); break; } }
    }
    nloc = mine > 0u ? mine : 1u; nx = cnt > 0u ? cnt : 1u;
}

__device__ __forceinline__ void xcd_barrier(const XcdBarrier& b) {
    asm volatile("s_waitcnt vmcnt(0)" ::: "memory");
    __syncthreads();
    if (threadIdx.x == 0) {
        unsigned* bar = b.bar;
        __builtin_amdgcn_s_waitcnt(0);
        unsigned nloc = b.st[0], nx = b.st[1];
        if (nloc == 0u) { xcd_barrier_complete(bar, b.x, nloc, nx); b.st[0] = nloc; b.st[1] = nx; }
        const unsigned old = xb_add(&bar[XB_XSUB(b.x)], 1u);
        const unsigned gen = old / nloc;
        if (old + 1u == (gen + 1u) * nloc) {
            __builtin_amdgcn_fence(__ATOMIC_RELEASE, "agent");
            asm volatile("s_waitcnt vmcnt(0)" ::: "memory");
            const unsigned og = xb_add(&bar[XB_TOP], 1u);
            const unsigned tg = og / nx;
            if (og + 1u == (tg + 1u) * nx) xb_add(&bar[XB_TOPGEN], 1u);
            else XB_SPIN(xb_ld(&bar[XB_TOPGEN]) == tg, bar);
            __builtin_amdgcn_fence(__ATOMIC_ACQUIRE, "agent");
            xb_add(&bar[XB_XGEN(b.x)], 1u);
            asm volatile("s_waitcnt vmcnt(0)" ::: "memory");
        } else {
            XB_SPIN(xb_ld(&bar[XB_XGEN(b.x)]) == gen, bar);
            __builtin_amdgcn_fence(__ATOMIC_ACQUIRE, "agent");
            asm volatile("s_waitcnt vmcnt(0)" ::: "memory");
        }
    }
    __syncthreads();
}

DEVI void gbar(unsigned* ctr, unsigned target) {
  asm volatile("s_waitcnt vmcnt(0)" ::: "memory");
  __syncthreads();
  if (threadIdx.x == 0) {
    __builtin_amdgcn_fence(__ATOMIC_RELEASE, "agent");
    asm volatile("s_waitcnt vmcnt(0)" ::: "memory");
    __hip_atomic_fetch_add(ctr, 1u, __ATOMIC_RELAXED, __HIP_MEMORY_SCOPE_AGENT);
    while (__hip_atomic_load(ctr, __ATOMIC_RELAXED, __HIP_MEMORY_SCOPE_AGENT) < target) __builtin_amdgcn_s_sleep(1);
    __builtin_amdgcn_fence(__ATOMIC_ACQUIRE, "agent");
    asm volatile("s_waitcnt vmcnt(0)" ::: "memory");
  }
  __syncthreads();
}

constexpr int NPHASE = 32;

DEVI void run_phase(const P& p, int ph, char* smem) {
  const int nb = gridDim.x, b0 = blockIdx.x;
  if (ph == 0) {
    const int total = CONV_ITEMS + 288 + 16;
    for (int it = b0; it < total; it += nb) {
      if (it < 288) mods_item(p, it, smem);
      else if (it < 304) s5disc_item(p, it - 288);
      else {
        const int cnt[13] = {1408, 1408, 704, 704, 102 * 16, 64, 64, 64, 64, 256, 16, 24, 16};
        int job = 0, r = it - 304;
#pragma unroll
        for (int j = 0; j < 13; ++j) { if (job == j && r >= cnt[j]) { r -= cnt[j]; job = j + 1; } }
        conv_tile(p, 0, job, r, smem);
      }
    }
    return;
  }
  if (ph == 1) {
    phase_rowpass(p, true, false, 0.f, p.mod, 0, p.norm_post, true, p.mod, 0, p.norm_pre);
    return;
  }
  const int l = (ph - 2) / 15, q = (ph - 2) % 15;
  const float* modl = p.mod + (long)l * 3 * 9216;
  switch (q) {
    case 0:
      if (l == 1) phase_conv(p, 1, smem, b0, nb);
      break;
    case 1: phase_ffn1(p, 0, smem); break;
    case 2: phase_gemm_plain128(p.UZ, DFF, p.W2, DFF, 1024, p.Y, DM, smem); break;
    case 3:
      phase_rowpass(p, l == 0, true, 0.5f, modl, 2, p.norm_post + (l * 3 + 0) * DM, true, modl, 3, p.norm_pre + (l * 3 + 1) * DM);
      break;
    case 4: phase_gemm_plain128(p.H, DM, p.WIN, 1024, ZLD, p.UZ, ZLD, smem); break;
    case 5: {
      for (int it = b0; it < 8840; it += nb) {
        if (it < 1040) mla_q_tile(p, it >> 2, it & 3, smem);
        else if (it < 2080) mla_kv_tile(p, (it - 1040) >> 2, (it - 1040) & 3, smem);
        else if (it < 2600) rowprep_item(p, l, it - 2080, smem);
        else if (it < 4680) s5_local_item(p, l, it - 2600, smem);
        else hgrn_local_item(p, l, it - 4680, smem);
      }
    } break;
    case 6: {
      for (int it = b0; it < 256 + 16 + 1560; it += nb) {
        if (it < 256) hgrn_scan_item(p, it);
        else if (it < 272) s5_scan_item(p, l, it - 256);
        else attn_dispatch(p, it - 272, smem);
      }
    } break;
    case 7: {
      for (int it = b0; it < 1040 + 2080; it += nb) {
        if (it < 1040) s5_out_item(p, l, it, smem);
        else hgrn_out_item(p, l, it - 1040, smem);
        __syncthreads();
      }
    } break;
    case 8: phase_glu(p, smem); break;
    case 9: phase_merge(p, smem); break;
    case 10: phase_gemm_plain128(p.UZ, DM, p.WOUT, 1024, 1024, p.Y, DM, smem); break;
    case 11:
      phase_rowpass(p, false, true, 1.0f, modl, 5, p.norm_post + (l * 3 + 1) * DM, true, modl, 6, p.norm_pre + (l * 3 + 2) * DM);
      break;
    case 12: phase_ffn1(p, 1, smem); break;
    case 13: phase_gemm_plain128(p.UZ, DFF, p.W2 + (long)1024 * DFF, DFF, 1024, p.Y, DM, smem); break;
    case 14:
      phase_rowpass(p, false, true, 0.5f, modl, 8, p.norm_post + (l * 3 + 2) * DM, l == 0, p.mod + (long)3 * 9216, 0, p.norm_pre + (3 + 0) * DM);
      break;
  }
}

__global__ void __launch_bounds__(256, 2) fwd_kernel(P p, int ph_begin, int ph_end) {
  __shared__ __attribute__((aligned(16))) char smem[SMEM_BYTES];
  if (ph_end - ph_begin == 1) {
    run_phase(p, ph_begin, smem);
    return;
  }
  cg::grid_group grid = cg::this_grid();
  __shared__ uint4 xb_words;
  if (threadIdx.x == 0) xb_words = make_uint4(0u, 0u, 0u, 0u);
  __syncthreads();
  XcdBarrier xb = xcd_barrier_post(p.bar, (volatile LAS unsigned*)&xb_words);
  for (int ph = ph_begin; ph < ph_end; ++ph) {
    if (ph == 2) continue;
    run_phase(p, ph, smem);
    if (ph + 1 < ph_end) {
      if (ph_end < 0) grid.sync();
      xcd_barrier(xb);
    }
  }
}

extern "C" void kernel_launch(void* const* d_in, const int* in_sizes, int n_in, void* d_out, int out_size, void* d_ws, size_t ws_size,
                              hipStream_t stream) {
  P p{};
  const float** pp = reinterpret_cast<const float**>(&p);
  for (int i = 0; i < 31; ++i) pp[i] = (const float*)d_in[i];
  p.out = (float*)d_out;
  char* ws = (char*)d_ws;
  size_t off = 0;
  auto take = [&](size_t bytes) { char* r = ws + off; off += (bytes + 255) & ~(size_t)255; return r; };
  p.W13 = (bf*)take((size_t)2 * 5632 * 1024 * 2);
  p.W2 = (bf*)take((size_t)2 * 1024 * DFF * 2);
  p.WIN = (bf*)take((size_t)NIN * 1024 * 2);
  p.WB = (bf*)take((size_t)4 * 1024 * 256 * 2);
  p.WOUT = (bf*)take((size_t)1024 * 1024 * 2);
  p.WGLU = (bf*)take((size_t)256 * 256 * 2);
  p.WUQ = (bf*)take((size_t)512 * 192 * 2);
  p.WUKV = (bf*)take((size_t)512 * 128 * 2);
  p.H = (bf*)take((size_t)NR * 1024 * 2);
  p.UZ = (bf*)take((size_t)NR * DFF * 2);
  {
    char* y = take((size_t)NR * 1024 * 2);
    p.Y = (bf*)y;
    p.hS = (bf*)y;
    p.Qd = (bf*)(y + 34078720);
    p.Kd = (bf*)(y + 34078720 + 17039360);
    p.VdT = (bf*)(y + 34078720 + 17039360 + 8519680);
  }
  {
    char* q = take((size_t)NR * 1024 * 2);
    p.Qb = (bf*)q;
    p.Kb = (bf*)(q + 25559040);
    p.Vtb = (bf*)(q + 2 * 25559040);
    p.gbuf = (bf*)q;
  }
  p.BR = (bf*)take((size_t)NR * 1024 * 2);
  p.xctx = (float*)take((size_t)512 * 1024 * 4);
  p.mod = (float*)take((size_t)2 * 3 * 9216 * 4);
  p.s5A = (float*)take((size_t)2 * 2 * 16 * 64 * 2 * 4);
  p.s5Bre = (float*)take((size_t)2 * 2 * 16 * 16 * 64 * 4);
  p.s5Bim = (float*)take((size_t)2 * 2 * 16 * 16 * 64 * 4);
  p.s5E = (float*)take((size_t)2 * 2 * 130 * 1024 * 8);
  p.s5Cin = (float*)take((size_t)2 * 2 * 130 * 1024 * 8);
  p.hD = (float*)take((size_t)2 * 2 * 4 * 260 * 64 * 4);
  p.bar = (unsigned*)take(XCD_BAR_WORDS * 4);
  if (off > ws_size) { fprintf(stderr, "kernel_launch: workspace too small: need %zu have %zu\n", off, ws_size); return; }

  static int grid_blocks = 0;
  if (!grid_blocks) {
    int dev = 0, cus = 0, per_cu = 0;
    hipGetDevice(&dev);
    hipDeviceGetAttribute(&cus, hipDeviceAttributeMultiprocessorCount, dev);
    hipOccupancyMaxActiveBlocksPerMultiprocessor(&per_cu, fwd_kernel, 256, 0);
    if (per_cu > 2) per_cu = 2;
    if (per_cu < 1) per_cu = 1;
    grid_blocks = cus * per_cu;
  }
#if MULTI_LAUNCH
  for (int ph = 0; ph < NPHASE; ++ph) {
    if (ph == 2) continue;
    hipLaunchKernelGGL(fwd_kernel, dim3(grid_blocks), dim3(256), 0, stream, p, ph, ph + 1);
  }
#else
  hipMemsetAsync(p.bar, 0, XCD_BAR_WORDS * 4, stream);
  int b = 0, e = NPHASE;
  void* args[] = {&p, &b, &e};
  hipError_t err = hipLaunchCooperativeKernel((void*)fwd_kernel, dim3(grid_blocks), dim3(256), args, 0, stream);
  if (err != hipSuccess) fprintf(stderr, "cooperative launch failed: %s (grid %d)\n", hipGetErrorString(err), grid_blocks);
#endif
}
```
